# Optimizing an MI355X kernel written in HIP

```python
import math
import jax
import jax.numpy as jnp
from jax import lax
import numpy as np

D_MODEL = 1024
BATCH = 8
SEQ = 4096
DEPTH = 1

EPS = 1e-6
NEG = -1e30
SGU_WIDTH = 1024
SGU_GROUPS = 8
SGU_GROUP_DIM = SGU_WIDTH // SGU_GROUPS
CHUNK = 128
ATT_HEADS = 8
ATT_HEAD_DIM = 128
ATT_WIDTH = ATT_HEADS * ATT_HEAD_DIM
MOBA_BLOCK = 256
MOBA_TOPK = 3
Q_BLOCK = 64
NUM_BUCKETS = 32
MAX_DISTANCE = 128
IN_WIDTH = 2 * SGU_WIDTH + 3 * ATT_WIDTH
N_BRANCH = 2
MEM_LEN = 256
X_HEADS = 4
X_HEAD_DIM = 128
X_WIDTH = X_HEADS * X_HEAD_DIM
N_GROUPS = 8
EXPERTS_PER_GROUP = 8
N_EXPERTS = N_GROUPS * EXPERTS_PER_GROUP
TOP_K_EXPERTS = 2
EXPERT_HIDDEN = 512
MOE_BLOCK = 256

kernel_name = 'hybrid_sgu_moba_hmoe_block'


def rmsnorm(x, g):
    xf = x.astype(jnp.float32)
    y = xf * lax.rsqrt(jnp.mean(xf * xf, axis=-1, keepdims=True) + EPS)
    return (y * g.astype(jnp.float32)).astype(x.dtype)


def rel_bucket(dist):
    n = jnp.maximum(dist, 0)
    max_exact = NUM_BUCKETS // 2
    nf = jnp.maximum(n, 1).astype(jnp.float32)
    large = max_exact + (jnp.log(nf / max_exact) / math.log(MAX_DISTANCE / max_exact)
                         * (NUM_BUCKETS - max_exact)).astype(jnp.int32)
    large = jnp.minimum(large, NUM_BUCKETS - 1)
    return jnp.where(n < max_exact, n, large)


def chunked_sgu(u_pre, v_pre, sgu_norm, w_spatial, b_spatial):
    B, S, _ = u_pre.shape
    u = jax.nn.gelu(u_pre)
    v = rmsnorm(jax.nn.gelu(v_pre), sgu_norm)
    v = v.reshape(B, S // CHUNK, CHUNK, SGU_GROUPS, SGU_GROUP_DIM)
    causal = jnp.tril(jnp.ones((CHUNK, CHUNK), dtype=bool))
    w = jnp.where(causal[None], w_spatial, jnp.zeros((), w_spatial.dtype))
    mixed = jnp.einsum('gts,bcsgd->bctgd', w, v) + b_spatial.T[None, None, :, :, None]
    return u * mixed.reshape(B, S, SGU_WIDTH)


def moba_attention(q, k, v, rel_bias):
    B, S, H, Dh = q.shape
    Sp = -(-S // MOBA_BLOCK) * MOBA_BLOCK
    pad = ((0, 0), (0, Sp - S), (0, 0), (0, 0))
    q, k, v = jnp.pad(q, pad), jnp.pad(k, pad), jnp.pad(v, pad)
    NB = Sp // MOBA_BLOCK
    NQ = Sp // Q_BLOCK
    K = min(MOBA_TOPK, NB)
    scale = Dh ** -0.5
    kb = k.transpose(0, 2, 1, 3).reshape(B, H, NB, MOBA_BLOCK, Dh)
    vb = v.transpose(0, 2, 1, 3).reshape(B, H, NB, MOBA_BLOCK, Dh)
    kmean = jnp.mean(kb.astype(jnp.float32), axis=3)
    qb = q.transpose(0, 2, 1, 3).reshape(B, H, NQ, Q_BLOCK, Dh).transpose(0, 2, 1, 3, 4)
    bias_hb = rel_bias.T.astype(jnp.float32)
    offs = jnp.arange(MOBA_BLOCK, dtype=jnp.int32)
    h_idx = jnp.arange(H)[:, None, None, None]

    def per_batch(args):
        qb_b, kb_b, vb_b, km_b = args

        def per_qblock(a):
            qblk, iq = a
            t = iq * Q_BLOCK + jnp.arange(Q_BLOCK, dtype=jnp.int32)
            cur = (iq * Q_BLOCK) // MOBA_BLOCK
            gate = jnp.einsum('hqd,hnd->hqn', qblk.astype(jnp.float32), km_b)
            past = jnp.arange(NB) < cur
            gate = jnp.where(past[None, None, :], gate, NEG)
            _, idx = lax.top_k(gate, K)
            valid = jnp.arange(K) < cur
            kg = jax.vmap(lambda kbh, ih: kbh[ih])(kb_b, idx)
            vg = jax.vmap(lambda vbh, ih: vbh[ih])(vb_b, idx)
            s_sel = jnp.einsum('hqd,hqrkd->hqrk', qblk, kg).astype(jnp.float32) * scale
            kpos_sel = idx[..., None] * MOBA_BLOCK + offs
            dist_sel = t[None, :, None, None] - kpos_sel
            s_sel = s_sel + bias_hb[h_idx, rel_bucket(dist_sel)]
            s_sel = jnp.where(valid[None, None, :, None], s_sel, NEG)
            ko = lax.dynamic_index_in_dim(kb_b, cur, axis=1, keepdims=False)
            vo = lax.dynamic_index_in_dim(vb_b, cur, axis=1, keepdims=False)
            s_own = jnp.einsum('hqd,hkd->hqk', qblk, ko).astype(jnp.float32) * scale
            dist_own = t[:, None] - (cur * MOBA_BLOCK + offs)[None, :]
            s_own = s_own + bias_hb[:, rel_bucket(dist_own)]
            s_own = jnp.where(dist_own[None] >= 0, s_own, NEG)
            logits = jnp.concatenate([s_sel.reshape(H, Q_BLOCK, K * MOBA_BLOCK), s_own], axis=-1)
            p = jax.nn.softmax(logits, axis=-1).astype(vb_b.dtype)
            p_sel = p[..., :K * MOBA_BLOCK].reshape(H, Q_BLOCK, K, MOBA_BLOCK)
            p_own = p[..., K * MOBA_BLOCK:]
            return (jnp.einsum('hqrk,hqrkd->hqd', p_sel, vg)
                    + jnp.einsum('hqk,hkd->hqd', p_own, vo))

        return lax.map(per_qblock, (qb_b, jnp.arange(NQ, dtype=jnp.int32)))

    out = lax.map(per_batch, (qb, kb, vb, kmean))
    out = out.transpose(0, 1, 3, 2, 4).reshape(B, Sp, H * Dh)
    return out[:, :S]


def token_mixer(xn, w_in, w_gate, b_gate, sgu_norm, w_spatial, b_spatial,
                w_branch_a, w_branch_b, rel_bias, w_o):
    B, S, D = xn.shape
    z = xn @ w_in
    u_pre, v_pre, q, k, v = jnp.split(
        z, [SGU_WIDTH, 2 * SGU_WIDTH, 2 * SGU_WIDTH + ATT_WIDTH, 2 * SGU_WIDTH + 2 * ATT_WIDTH], axis=-1)
    y_a = chunked_sgu(u_pre, v_pre, sgu_norm, w_spatial, b_spatial) @ w_branch_a
    att = moba_attention(q.reshape(B, S, ATT_HEADS, ATT_HEAD_DIM),
                         k.reshape(B, S, ATT_HEADS, ATT_HEAD_DIM),
                         v.reshape(B, S, ATT_HEADS, ATT_HEAD_DIM), rel_bias)
    y_b = att @ w_branch_b
    gates = jax.nn.sigmoid((xn @ w_gate).astype(jnp.float32) + b_gate.astype(jnp.float32))
    gates = gates.reshape(B, S, N_BRANCH, D).astype(xn.dtype)
    merged = gates[:, :, 0] * y_a + gates[:, :, 1] * y_b
    return merged @ w_o


def mem_cross_attention(xn, memn, w_xq, w_xkv, w_xo):
    B, S, _ = xn.shape
    M = memn.shape[1]
    q = (xn @ w_xq).reshape(B, S, X_HEADS, X_HEAD_DIM)
    kv = (memn @ w_xkv).reshape(B, M, 2, X_HEADS, X_HEAD_DIM)
    k, v = kv[:, :, 0], kv[:, :, 1]
    s = jnp.einsum('bqhd,bmhd->bhqm', q, k).astype(jnp.float32) * (X_HEAD_DIM ** -0.5)
    p = jax.nn.softmax(s, axis=-1).astype(v.dtype)
    o = jnp.einsum('bhqm,bmhd->bqhd', p, v).reshape(B, S, X_WIDTH)
    return o @ w_xo


def hier_moe(xn, w_rg, b_rg, w_re, b_re, w_e_gate, w_e_up, w_e_down):
    B, S, D = xn.shape
    T = B * S
    xt = xn.reshape(T, D)
    g_logits = (xt @ w_rg).astype(jnp.float32) + b_rg.astype(jnp.float32)
    p_g = jax.nn.softmax(g_logits, axis=-1)
    gsel = jnp.argmax(g_logits, axis=-1).astype(jnp.int32)
    pg_sel = jnp.take_along_axis(p_g, gsel[:, None], axis=-1)
    e_logits = ((xt @ w_re).astype(jnp.float32) + b_re.astype(jnp.float32)).reshape(T, N_GROUPS, EXPERTS_PER_GROUP)
    e_logits = jnp.take_along_axis(e_logits, gsel[:, None, None], axis=1)[:, 0]
    p_e = jax.nn.softmax(e_logits, axis=-1)
    top_p, top_e = lax.top_k(p_e, TOP_K_EXPERTS)
    top_p = top_p / jnp.sum(top_p, axis=-1, keepdims=True)
    weights = pg_sel * top_p
    expert_id = gsel[:, None] * EXPERTS_PER_GROUP + top_e
    P = T * TOP_K_EXPERTS
    eid = expert_id.reshape(P)
    tok = jnp.repeat(jnp.arange(T, dtype=jnp.int32), TOP_K_EXPERTS)
    wt = weights.reshape(P)
    order = jnp.argsort(eid)
    eid_s, tok_s, wt_s = eid[order], tok[order], wt[order]
    counts = jnp.bincount(eid, length=N_EXPERTS)
    starts = jnp.cumsum(counts) - counts
    padded = (counts + MOE_BLOCK - 1) // MOE_BLOCK * MOE_BLOCK
    pad_ends = jnp.cumsum(padded)
    pad_starts = pad_ends - padded
    dest = pad_starts[eid_s] + jnp.arange(P, dtype=jnp.int32) - starts[eid_s]
    NBLK = -(-P // MOE_BLOCK) + N_EXPERTS
    buf = jnp.zeros((NBLK * MOE_BLOCK, D), xt.dtype).at[dest].set(xt[tok_s])
    blk_expert = jnp.minimum(
        jnp.searchsorted(pad_ends, jnp.arange(NBLK, dtype=jnp.int32) * MOE_BLOCK, side='right'),
        N_EXPERTS - 1)

    def expert_block(a):
        xb, e = a
        hdn = jax.nn.silu(xb @ w_e_gate[e]) * (xb @ w_e_up[e])
        return hdn @ w_e_down[e]

    ybuf = lax.map(expert_block, (buf.reshape(NBLK, MOE_BLOCK, D), blk_expert)).reshape(NBLK * MOE_BLOCK, D)
    y = jnp.zeros((T, D), ybuf.dtype).at[tok_s].add(wt_s[:, None].astype(ybuf.dtype) * ybuf[dest])
    return y.reshape(B, S, D)


def setup_inputs(seed: int = 0) -> dict:
    key = jax.random.key(seed)
    ks = jax.random.split(key, 32)
    f32 = jnp.float32
    L = DEPTH
    D = D_MODEL

    def nrm(k, shape, scale):
        return jax.random.normal(k, shape, f32) * scale

    return {
        'x': nrm(ks[0], (BATCH, SEQ, D), 1.0),
        'mem': nrm(ks[1], (BATCH, MEM_LEN, D), 1.0),
        'norm_mix': 1.0 + nrm(ks[2], (L, D), 0.1),
        'w_in': nrm(ks[3], (L, D, IN_WIDTH), D ** -0.5),
        'w_gate': nrm(ks[4], (L, D, N_BRANCH * D), D ** -0.5),
        'b_gate': nrm(ks[5], (L, N_BRANCH * D), 0.1),
        'sgu_norm': 1.0 + nrm(ks[6], (L, SGU_WIDTH), 0.1),
        'w_spatial': nrm(ks[7], (L, SGU_GROUPS, CHUNK, CHUNK), CHUNK ** -0.5),
        'b_spatial': 1.0 + nrm(ks[8], (L, SGU_GROUPS, CHUNK), 0.1),
        'w_branch_a': nrm(ks[9], (L, SGU_WIDTH, D), SGU_WIDTH ** -0.5),
        'w_branch_b': nrm(ks[10], (L, ATT_WIDTH, D), ATT_WIDTH ** -0.5),
        'rel_bias': nrm(ks[11], (NUM_BUCKETS, ATT_HEADS), 0.3),
        'w_o': nrm(ks[12], (L, D, D), D ** -0.5),
        'norm_x': 1.0 + nrm(ks[13], (L, D), 0.1),
        'norm_mem': 1.0 + nrm(ks[14], (L, D), 0.1),
        'w_xq': nrm(ks[15], (L, D, X_WIDTH), D ** -0.5),
        'w_xkv': nrm(ks[16], (L, D, 2 * X_WIDTH), D ** -0.5),
        'w_xo': nrm(ks[17], (L, X_WIDTH, D), X_WIDTH ** -0.5),
        'norm_ffn': 1.0 + nrm(ks[18], (L, D), 0.1),
        'w_router_group': nrm(ks[19], (L, D, N_GROUPS), D ** -0.5),
        'b_router_group': nrm(ks[20], (L, N_GROUPS), 0.01),
        'w_router_expert': nrm(ks[21], (L, D, N_EXPERTS), D ** -0.5),
        'b_router_expert': nrm(ks[22], (L, N_EXPERTS), 0.01),
        'w_e_gate': nrm(ks[23], (L, N_EXPERTS, D, EXPERT_HIDDEN), D ** -0.5),
        'w_e_up': nrm(ks[24], (L, N_EXPERTS, D, EXPERT_HIDDEN), D ** -0.5),
        'w_e_down': nrm(ks[25], (L, N_EXPERTS, EXPERT_HIDDEN, D), EXPERT_HIDDEN ** -0.5),
        'norm_final': 1.0 + nrm(ks[26], (D,), 0.1),
    }


def reference(x, mem, norm_mix, w_in, w_gate, b_gate, sgu_norm, w_spatial, b_spatial,
              w_branch_a, w_branch_b, rel_bias, w_o, norm_x, norm_mem, w_xq, w_xkv, w_xo,
              norm_ffn, w_router_group, b_router_group, w_router_expert, b_router_expert,
              w_e_gate, w_e_up, w_e_down, norm_final):
    h = x
    for l in range(DEPTH):
        h = h + token_mixer(rmsnorm(h, norm_mix[l]), w_in[l], w_gate[l], b_gate[l], sgu_norm[l],
                            w_spatial[l], b_spatial[l], w_branch_a[l], w_branch_b[l], rel_bias, w_o[l])
        h = h + mem_cross_attention(rmsnorm(h, norm_x[l]), rmsnorm(mem, norm_mem[l]),
                                    w_xq[l], w_xkv[l], w_xo[l])
        h = h + hier_moe(rmsnorm(h, norm_ffn[l]), w_router_group[l], b_router_group[l],
                         w_router_expert[l], b_router_expert[l], w_e_gate[l], w_e_up[l], w_e_down[l])
    return rmsnorm(h, norm_final)
```

```cpp
#include <hip/hip_runtime.h>
#include <hip/hip_bf16.h>
#include <hip/hip_cooperative_groups.h>
#include <cstdio>
#include <cstdint>
namespace cg = cooperative_groups;
namespace pg8 {
#define PG8_LAS __attribute__((address_space(3)))
typedef unsigned short bf16_t;
typedef short bf16x8 __attribute__((ext_vector_type(8)));
typedef float f32x4 __attribute__((ext_vector_type(4)));
typedef unsigned u32x4 __attribute__((ext_vector_type(4)));
typedef int v8i32 __attribute__((ext_vector_type(8)));
constexpr int BM = 256, BK = 64, HALF = 128, HTB = HALF * BK * 2  , STAGE_BYTES = 8 * HTB, NXCD = 8, WGM = 8;

__host__ __device__ __forceinline__ int lds_byte(int r, int c) { const int st = (r >> 4) * 2 + (c >> 5), rr = r & 15, cc = c & 31, ob = rr * 64 + cc * 2; return st * 1024 + (ob ^ (((ob >> 9) & 1) << 5)); }
__host__ __device__ __forceinline__ void stage_rc(int b, int& R, int& C) { const int st = b / 1024, sb = b % 1024, swz = sb ^ (((sb >> 9) & 1) << 5); R = (st >> 1) * 16 + swz / 64; C = (st & 1) * 32 + (swz % 64) / 2; }
__host__ __device__ __forceinline__ int perm32(int rho) { const int n = rho >> 4, i = rho & 15; return 8 * (i >> 2) + 4 * n + (i & 3); }

struct Unit { int pm, pn; const char* A; const char* B; int aux; int ord; };
__device__ __forceinline__ unsigned cvt_pk_bf16(float lo, float hi) { unsigned r; asm volatile("v_cvt_pk_bf16_f32 %0, %1, %2" : "=v"(r) : "v"(lo), "v"(hi)); return r; }
template <class Epi, class Sched, bool ALIGN_EPI = false, bool SP2 = false, bool GATHER = false, bool FP8 = false>
__device__ __forceinline__ void gemm_phase(PG8_LAS unsigned char* lds, const int tid, const int K_, const Sched& S, const Epi& E) {
    int K = K_; if constexpr (FP8) asm volatile("" : "+s"(K));
    const int wid = __builtin_amdgcn_readfirstlane(tid >> 6), lane = tid & 63, wr = wid >> 2, wc = wid & 3, fr = lane & 15, fq = lane >> 4;
    const int nt = K / BK;
    unsigned voffA[2], voffB[2];
#pragma unroll
    for (int i = 0; i < 2; ++i) { int R, C; stage_rc(tid * 16 + i * 8192, R, C); const int Rb = Epi::PERM ? ((R & ~31) + perm32(R & 31)) : R;
        voffA[i] = (unsigned)(R * K + C) * 2u; voffB[i] = (unsigned)(Rb * K + C) * 2u; }
    unsigned vA[2][2], vAn[2][2];
    const size_t kstep = (size_t)(BK * 2);
    const size_t hstep = (size_t)HALF * K * 2;
#pragma unroll
    for (int h = 0; h < 2; ++h)
#pragma unroll
        for (int i = 0; i < 2; ++i) { vA[h][i] = voffA[i]; vAn[h][i] = vA[h][i]; }
#define PG8_ROWS(dst, u_) do { const unsigned* rt_ = S.rowtab(u_); int gR[2]; unsigned gC[2]; { int l2_ = lane; if constexpr (FP8) asm volatile("v_mbcnt_lo_u32_b32 %0, -1, 0\n\tv_mbcnt_hi_u32_b32 %0, -1, %0" : "=v"(l2_)); \
        _Pragma("unroll") for (int i = 0; i < 2; ++i) { int R, C; stage_rc((wid * 64 + l2_) * 16 + i * 8192, R, C); gR[i] = R; gC[i] = (unsigned)C * 2u; } }     \
        unsigned x0, x1, x2, x3; const PG8_LAS unsigned* lt_ = S.rowtab_lds(u_); \
        if (lt_) { x0 = lt_[gR[0]]; x1 = lt_[gR[1]]; x2 = lt_[128 + gR[0]]; x3 = lt_[128 + gR[1]]; asm volatile("s_waitcnt lgkmcnt(0)" : "+v"(x0), "+v"(x1), "+v"(x2), "+v"(x3) :: "memory"); }     \
        else { x0 = rt_[gR[0]]; x1 = rt_[gR[1]]; x2 = rt_[128 + gR[0]]; x3 = rt_[128 + gR[1]]; \
        asm volatile("s_waitcnt vmcnt(0)" : "+v"(x0), "+v"(x1), "+v"(x2), "+v"(x3) :: "memory"); }     \
        dst[0][0] = x0 + gC[0]; dst[0][1] = x1 + gC[1]; dst[1][0] = x2 + gC[0]; dst[1][1] = x3 + gC[1]; } while (0)
    const unsigned ldsw = (unsigned)wid * 1024u;
    const int aoff = lds_byte(wr * 64 + fr, fq * 8), boff = lds_byte(wc * 32 + fr, fq * 8);
    int boffB = boff + 4 * HTB; if constexpr (FP8) asm volatile("" : "+v"(boffB));
#define PG8_SA(b, h) (((b) * 2 + (h)) * HTB)
#define PG8_SB(b, h) ((4 + (b) * 2 + (h)) * HTB)
#define PG8_STAGE(bufoff, gbase, voff) do { const char* gb_ = (const char*)(gbase); if constexpr (FP8) asm volatile("" : "+s"(gb_)); _Pragma("unroll") for (int _i = 0; _i < 2; ++_i) { \
        unsigned vo_ = (voff)[_i]; if constexpr (FP8) asm volatile("" : "+v"(vo_)); \
        __builtin_amdgcn_global_load_lds((const unsigned*)(gb_ + vo_), (PG8_LAS unsigned*)(lds + (bufoff) + ldsw + _i * 8192), 16, 0, 0); } } while (0)
#define PG8_AH1(p_) (GATHER ? (p_) : (p_) + hstep)
#define PG8_VH1(v_) (GATHER ? v_[1] : v_[0])
#define PG8_LDA8(dst, b, h) do { _Pragma("unroll") for (int m = 0; m < 4; ++m) dst[m] = PG8_CAT(*(const PG8_LAS bf16x8*)(lds + PG8_SA(b, h) + aoff + m * 2048), *(const PG8_LAS bf16x8*)(lds + PG8_SA(b, h) + aoff + m * 2048 + 1024)); } while (0)
#define PG8_LDB8(dst, b, h) do { _Pragma("unroll") for (int n = 0; n < 2; ++n) dst[n] = PG8_CAT(*(const PG8_LAS bf16x8*)(lds + boffB + ((b) * 2 + (h)) * HTB + n * 2048), *(const PG8_LAS bf16x8*)(lds + boffB + ((b) * 2 + (h)) * HTB + n * 2048 + 1024)); } while (0)
#define PG8_LDA(dst, b, h) do { if constexpr (FP8) { PG8_LDA8(dst##8, b, h); } else { _Pragma("unroll") for (int m = 0; m < 4; ++m) _Pragma("unroll") for (int k = 0; k < 2; ++k) dst[m][k] = *(const PG8_LAS bf16x8*)(lds + PG8_SA(b, h) + aoff + m * 2048 + k * 1024); } } while (0)
#define PG8_LDB(dst, b, h) do { if constexpr (FP8) { PG8_LDB8(dst##8, b, h); } else { _Pragma("unroll") for (int n = 0; n < 2; ++n) _Pragma("unroll") for (int k = 0; k < 2; ++k) dst[n][k] = *(const PG8_LAS bf16x8*)(lds + PG8_SB(b, h) + boff + n * 2048 + k * 1024); } } while (0)
#define PG8_CAT(x, y) __builtin_bit_cast(v8i32, __builtin_shufflevector(x, y, 0, 1, 2, 3, 4, 5, 6, 7, 8, 9, 10, 11, 12, 13, 14, 15))
#define PG8_MMA(ai, bj, At, Bt) do { __builtin_amdgcn_s_setprio(1); _Pragma("unroll") for (int m = 0; m < 4; ++m) _Pragma("unroll") for (int n = 0; n < 2; ++n) { \
        if constexpr (FP8) acc[ai][bj][m][n] = __builtin_amdgcn_mfma_scale_f32_16x16x128_f8f6f4(Bt##8[n], At##8[m], acc[ai][bj][m][n], 0, 0, 0, 0x7f7f7f7f, 0, 0x7f7f7f7f); \
        else { _Pragma("unroll") for (int k = 0; k < 2; ++k) acc[ai][bj][m][n] = __builtin_amdgcn_mfma_f32_16x16x32_bf16(Bt[n][k], At[m][k], acc[ai][bj][m][n], 0, 0, 0); } } __builtin_amdgcn_s_setprio(0); } while (0)
#define PG8_WAIT_V(n) asm volatile("s_waitcnt vmcnt(" #n ")" ::: "memory")
#define PG8_WAIT_L(n) asm volatile("s_waitcnt lgkmcnt(" #n ")" ::: "memory")
#define PG8_BAR __builtin_amdgcn_s_barrier()
#define PG8_SCHED do { if constexpr (!FP8) __builtin_amdgcn_sched_barrier(0); } while (0)
    Unit cur, nxt; int ui = 0;
    if (!S.next(0, cur)) return;
    f32x4 acc[2][2][4][2];
#pragma unroll
    for (int a = 0; a < 2; ++a)
#pragma unroll
        for (int b = 0; b < 2; ++b)
#pragma unroll
            for (int m = 0; m < 4; ++m)
#pragma unroll
                for (int n = 0; n < 2; ++n) acc[a][b][m][n] = (f32x4){0.f, 0.f, 0.f, 0.f};
    bf16x8 At[4][2], B0[2][2], B1[2][2]; v8i32 At8[4], B08[2], B18[2];
    const char* cA = cur.A; const char* cB = cur.B;
    if constexpr (GATHER) { PG8_ROWS(vA, cur); }
    S.a_ready(cur);
    if constexpr (SP2) {
        PG8_STAGE(PG8_SB(0, 0), cB, voffB); PG8_STAGE(PG8_SB(0, 1), cB + hstep, voffB); PG8_STAGE(PG8_SA(0, 0), cA, vA[0]); PG8_STAGE(PG8_SA(0, 1), PG8_AH1(cA), PG8_VH1(vA));
        if (wr == 1) PG8_BAR;
        PG8_WAIT_V(2); PG8_BAR;
        PG8_STAGE(PG8_SB(1, 0), cB + kstep, voffB); PG8_STAGE(PG8_SA(1, 0), cA + kstep, vA[0]); PG8_STAGE(PG8_SB(1, 1), cB + hstep + kstep, voffB);
        PG8_WAIT_V(6); PG8_BAR;
    } else {
        PG8_STAGE(PG8_SB(0, 0), cB, voffB); PG8_STAGE(PG8_SA(0, 0), cA, vA[0]); PG8_STAGE(PG8_SB(0, 1), cB + hstep, voffB); PG8_STAGE(PG8_SA(0, 1), PG8_AH1(cA), PG8_VH1(vA));
        if (wr == 1) PG8_BAR;
        PG8_WAIT_V(4); PG8_BAR;
        PG8_STAGE(PG8_SB(1, 0), cB + kstep, voffB); PG8_STAGE(PG8_SA(1, 0), cA + kstep, vA[0]); PG8_STAGE(PG8_SB(1, 1), cB + hstep + kstep, voffB);
        PG8_WAIT_V(6); PG8_BAR;
    }
    for (;;) {
        const bool has_next = S.next(ui + 1, nxt);
        const char* nA = has_next ? nxt.A : cA; const char* nB = has_next ? nxt.B : cB;
        if constexpr (GATHER) { if (has_next) { PG8_ROWS(vAn, nxt); } else { vAn[0][0] = vA[0][0]; vAn[0][1] = vA[0][1]; vAn[1][0] = vA[1][0]; vAn[1][1] = vA[1][1]; } }
        for (int t = 0; t < nt; t += 2) {
            const bool last = (t == nt - 2);
            const char* a1 = cA + (size_t)(t + 1) * kstep;
            const char* a2 = last ? nA : cA + (size_t)(t + 2) * kstep; const char* b2 = last ? nB : cB + (size_t)(t + 2) * kstep;
            const char* a3 = a2 + kstep; const char* b3 = b2 + kstep;
            unsigned vX[2][2];
#pragma unroll
            for (int h = 0; h < 2; ++h)
#pragma unroll
                for (int i = 0; i < 2; ++i) vX[h][i] = (GATHER && last) ? vAn[h][i] : vA[h][i];
            if (last && has_next) S.a_ready(nxt);
            if constexpr (SP2) {
            PG8_LDB(B0, 0, 0); PG8_LDB(B1, 0, 1); PG8_SCHED; PG8_LDA(At, 0, 0); PG8_STAGE(PG8_SA(1, 1), PG8_AH1(a1), PG8_VH1(vA));
            PG8_WAIT_V(8); PG8_WAIT_L(0); PG8_BAR; PG8_MMA(0, 0, At, B0); PG8_MMA(0, 1, At, B1); PG8_BAR; PG8_SCHED;
            PG8_LDA(At, 0, 1); PG8_STAGE(PG8_SB(0, 0), b2, voffB); PG8_STAGE(PG8_SB(0, 1), b2 + hstep, voffB); PG8_STAGE(PG8_SA(0, 0), a2, vX[0]);
            PG8_WAIT_V(8); PG8_WAIT_L(0); PG8_BAR; PG8_MMA(1, 0, At, B0); PG8_MMA(1, 1, At, B1); PG8_BAR; PG8_SCHED;
            PG8_LDB(B0, 1, 0); PG8_LDB(B1, 1, 1); PG8_SCHED; PG8_LDA(At, 1, 0); PG8_STAGE(PG8_SA(0, 1), PG8_AH1(a2), PG8_VH1(vX));
            PG8_WAIT_V(8); PG8_WAIT_L(0); PG8_BAR; PG8_MMA(0, 0, At, B0); PG8_MMA(0, 1, At, B1); PG8_BAR; PG8_SCHED;
            PG8_LDA(At, 1, 1); PG8_STAGE(PG8_SB(1, 0), b3, voffB); PG8_STAGE(PG8_SB(1, 1), b3 + hstep, voffB); PG8_STAGE(PG8_SA(1, 0), a3, vX[0]);
            PG8_WAIT_V(8); PG8_WAIT_L(0); PG8_BAR; PG8_MMA(1, 0, At, B0); PG8_MMA(1, 1, At, B1); PG8_BAR; PG8_SCHED;
            } else {
            PG8_LDB(B0, 0, 0); PG8_SCHED; PG8_LDA(At, 0, 0); PG8_STAGE(PG8_SA(1, 1), PG8_AH1(a1), PG8_VH1(vA));
            PG8_WAIT_L(8); PG8_BAR; PG8_WAIT_L(0); PG8_MMA(0, 0, At, B0); PG8_BAR; PG8_SCHED;
            PG8_LDB(B1, 0, 1); PG8_STAGE(PG8_SB(0, 0), b2, voffB);
            PG8_BAR; PG8_WAIT_L(0); PG8_MMA(0, 1, At, B1); PG8_BAR;
            PG8_LDA(At, 0, 1); PG8_STAGE(PG8_SA(0, 0), a2, vX[0]);
            PG8_BAR; PG8_WAIT_L(0); PG8_MMA(1, 0, At, B0); PG8_BAR; PG8_SCHED;
            PG8_STAGE(PG8_SB(0, 1), b2 + hstep, voffB);
            PG8_WAIT_V(6); PG8_BAR; PG8_MMA(1, 1, At, B1); PG8_BAR;
            PG8_LDB(B0, 1, 0); PG8_SCHED; PG8_LDA(At, 1, 0); PG8_STAGE(PG8_SA(0, 1), PG8_AH1(a2), PG8_VH1(vX));
            PG8_WAIT_L(8); PG8_BAR; PG8_WAIT_L(0); PG8_MMA(0, 0, At, B0); PG8_BAR; PG8_SCHED;
            PG8_LDB(B1, 1, 1); PG8_STAGE(PG8_SB(1, 0), b3, voffB);
            PG8_BAR; PG8_WAIT_L(0); PG8_MMA(0, 1, At, B1); PG8_BAR;
            PG8_LDA(At, 1, 1); PG8_STAGE(PG8_SA(1, 0), a3, vX[0]);
            PG8_BAR; PG8_WAIT_L(0); PG8_MMA(1, 0, At, B0); PG8_BAR; PG8_SCHED;
            PG8_STAGE(PG8_SB(1, 1), b3 + hstep, voffB);
            PG8_WAIT_V(6); PG8_BAR; PG8_MMA(1, 1, At, B1); PG8_BAR;
            }
        }
        if constexpr (ALIGN_EPI) { if (wr == 0) PG8_BAR; }
        bool chained = false;
        if constexpr (Epi::CHAIN) chained = E.mid(acc, cur, wr, wc, fr, fq);
        if (!chained) { if constexpr (!Epi::AFTER_DRAIN) {
            if constexpr (FP8) { int l2; asm volatile("v_mbcnt_lo_u32_b32 %0, -1, 0\n\tv_mbcnt_hi_u32_b32 %0, -1, %0" : "=v"(l2));
                E(acc, cur, wr, wc, l2 & 15, l2 >> 4); }
            else E(acc, cur, wr, wc, fr, fq);
            S.done(cur); } }
        if (!has_next) break;
        if (!chained) {
#pragma unroll
        for (int a = 0; a < 2; ++a)
#pragma unroll
            for (int b = 0; b < 2; ++b)
#pragma unroll
                for (int m = 0; m < 4; ++m)
#pragma unroll
                    for (int n = 0; n < 2; ++n) acc[a][b][m][n] = (f32x4){0.f, 0.f, 0.f, 0.f};
        }
        cur = nxt; cA = nA; cB = nB; ++ui;
        if constexpr (GATHER) { vA[0][0] = vAn[0][0]; vA[0][1] = vAn[0][1]; vA[1][0] = vAn[1][0]; vA[1][1] = vAn[1][1]; }
        if constexpr (ALIGN_EPI) { if (wr == 1) PG8_BAR; }
    }
    PG8_WAIT_V(0);
    if constexpr (!ALIGN_EPI) { if (wr == 0) PG8_BAR; }
    PG8_BAR;
    if constexpr (Epi::AFTER_DRAIN) { E.fused(acc, cur, wr, wc, fr, fq, lds, wid, lane); S.done(cur); }
#undef PG8_SA
#undef PG8_ROWS
#undef PG8_SB
#undef PG8_STAGE
#undef PG8_LDA
#undef PG8_LDA8
#undef PG8_AH1
#undef PG8_VH1
#undef PG8_LDB8
#undef PG8_LDB
#undef PG8_MMA
#undef PG8_CAT
#undef PG8_WAIT_V
#undef PG8_WAIT_L
#undef PG8_BAR
#undef PG8_SCHED
}
}
#define LAS __attribute__((address_space(3)))
#define GAS __attribute__((address_space(1)))
typedef unsigned short bf16;
typedef unsigned v4u __attribute__((ext_vector_type(4)));
typedef unsigned v2u __attribute__((ext_vector_type(2)));
typedef float f32x4 __attribute__((ext_vector_type(4)));
typedef float f32x2 __attribute__((ext_vector_type(2)));
typedef short bf16x8 __attribute__((ext_vector_type(8)));

namespace mk {
constexpr int D = 1024, NB_ = 8, S = 4096, T = NB_ * S;
constexpr int INW = 5120, NCAT = 7168;
constexpr int H = 8, DH = 128, NBLK = 16;
constexpr int XH = 4, XW = 512, MEM = 256;
constexpr int NE = 64, EH = 512;
constexpr int MAXTILES = 320;
constexpr int MAXSLOTS = MAXTILES * 256;
constexpr float EPS = 1e-6f;
constexpr int NWAVES = 8, NTHREADS = 512;

constexpr size_t MiB = 1u << 20;
constexpr size_t WS_U    = 0;
constexpr size_t WS_GV   = 64 * MiB;
constexpr size_t WS_Q    = 128 * MiB;
constexpr size_t WS_V    = 192 * MiB;
constexpr size_t WS_K    = 256 * MiB;
constexpr size_t WS_G    = 320 * MiB;
constexpr size_t WS_W    = 448 * MiB;
constexpr size_t W_CAT = WS_W, W_A = W_CAT + 14 * MiB, W_B = W_A + 2 * MiB, W_O = W_B + 2 * MiB, W_XQ = W_O + 2 * MiB, W_XKV = W_XQ + 1 * MiB,
                 W_XO = W_XKV + 2 * MiB, W_R = W_XO + 1 * MiB, W_END = W_R + 1 * MiB;
constexpr size_t WS_KVM  = W_END;
constexpr size_t WS_KPART = WS_KVM + 4 * MiB;
constexpr size_t WS_VSTAT = WS_KPART + 1 * MiB;
constexpr size_t WS_ST1  = WS_VSTAT + 2 * MiB;
constexpr size_t WS_ST2  = WS_ST1 + 2 * MiB;
constexpr size_t WS_RL   = WS_ST2 + 2 * MiB;
constexpr size_t WS_WSP  = WS_RL + 16 * MiB;
constexpr size_t WS_BTAB = WS_WSP + 256 * 1024;
constexpr size_t WS_CTL  = WS_BTAB + 4096;
constexpr size_t WS_EID  = WS_CTL + 4096;
constexpr size_t WS_WT   = WS_EID + 256 * 1024;
constexpr size_t WS_PSLOT = WS_WT + 256 * 1024;
constexpr size_t WS_SLOTP = WS_PSLOT + 256 * 1024;
constexpr size_t WS_SLOTRS = WS_SLOTP + 512 * 1024;
constexpr size_t WS_SLOTOFF = WS_SLOTRS + 512 * 1024;
constexpr size_t WS_BAR  = WS_SLOTOFF + 512 * 1024;
constexpr size_t WS_END  = WS_BAR + 16384;
static_assert(WS_END <= 512 * MiB, "workspace map");
constexpr size_t WS_MERGED = WS_GV;
constexpr size_t WS_HB   = WS_K;
constexpr size_t WS_Q2   = WS_V;
constexpr size_t WS_WGU  = WS_G;
constexpr size_t WS_XG8  = WS_U + 32 * MiB;
constexpr float WGU_SCALE = 64.f, WD_SCALE = 32.f, HDN_SCALE = 4.f, Y_SCALE = 16.f;
constexpr size_t WS_XG   = WS_GV;
constexpr size_t WS_Y    = WS_GV;
constexpr size_t OUT_XN = 0;
constexpr size_t OUT_MEMN = 64 * MiB;
constexpr size_t OUT_WD  = 72 * MiB;
constexpr size_t OUT_HDN = 0;

constexpr int RING_BYTES = 131072;
constexpr int LDS_MISC = RING_BYTES;
constexpr int LDS_BYTES = 147456;

struct Params {
    const float *x, *mem, *norm_mix, *w_in, *w_gate, *b_gate, *sgu_norm, *w_spatial, *b_spatial, *w_branch_a, *w_branch_b, *rel_bias, *w_o, *norm_x, *norm_mem,
        *w_xq, *w_xkv, *w_xo, *norm_ffn, *w_rg, *b_rg, *w_re, *b_re, *w_e_gate, *w_e_up, *w_e_down, *norm_final;
    float* out; unsigned char* ws;
    int ph_lo, ph_hi;
};
typedef const Params __attribute__((address_space(4)))* PPtr;

__device__ __forceinline__ unsigned f2bf(float f) { unsigned u = __builtin_bit_cast(unsigned, f); return (u + 0x7fffu + ((u >> 16) & 1u)) >> 16; }
typedef __bf16 bf16x2_t __attribute__((ext_vector_type(2)));
__device__ __forceinline__ unsigned pk2(float lo, float hi) { const f32x2 v = {lo, hi}; const bf16x2_t b = __builtin_convertvector(v, bf16x2_t); return __builtin_bit_cast(unsigned, b); }
__device__ __forceinline__ unsigned pk4_fp8(float a, float b, float c, float d) { unsigned w = 0; w = __builtin_amdgcn_cvt_pk_fp8_f32(a, b, w, false); w = __builtin_amdgcn_cvt_pk_fp8_f32(c, d, w, true); return w; }
__device__ __forceinline__ f32x4 unpk4_fp8(unsigned w) { const f32x2 lo = __builtin_amdgcn_cvt_pk_f32_fp8(w, false), hi = __builtin_amdgcn_cvt_pk_f32_fp8(w, true); return (f32x4){lo.x, lo.y, hi.x, hi.y}; }
__device__ __forceinline__ unsigned pk4_u8(f32x4 g) {
    const unsigned q0 = (unsigned)(g[0] * 255.f + 0.5f), q1 = (unsigned)(g[1] * 255.f + 0.5f), q2 = (unsigned)(g[2] * 255.f + 0.5f), q3 = (unsigned)(g[3] * 255.f + 0.5f);
    return q0 | (q1 << 8) | (q2 << 16) | (q3 << 24); }
__device__ __forceinline__ f32x4 unpk4_u8(unsigned w) { return (f32x4){(float)(w & 0xffu), (float)((w >> 8) & 0xffu), (float)((w >> 16) & 0xffu), (float)(w >> 24)}; }
__device__ __forceinline__ float bf2f(unsigned short b) { return __builtin_bit_cast(float, (unsigned)b << 16); }
__device__ __forceinline__ float bflo(unsigned w) { return __builtin_bit_cast(float, w << 16); }
__device__ __forceinline__ float bfhi(unsigned w) { return __builtin_bit_cast(float, w & 0xffff0000u); }
__device__ __forceinline__ float wave_sum(float v) {
#pragma unroll
    for (int o = 1; o < 64; o <<= 1) v += __shfl_xor(v, o);
    return v;
}
__device__ __forceinline__ float fast_exp2(float x) { return __builtin_amdgcn_exp2f(x); }
__device__ __forceinline__ float fast_rcp(float x) { return __builtin_amdgcn_rcpf(x); }
__device__ __forceinline__ float gelu_tanh(float x) {
    const float k = -2.0f * 0.7978845608028654f * 1.4426950408889634f;
    const float u = x * (1.0f + 0.044715f * x * x);
    return x * fast_rcp(1.0f + fast_exp2(k * u));
}
__device__ __forceinline__ float sigmoid_f(float x) { return fast_rcp(1.0f + fast_exp2(-1.4426950408889634f * x)); }
}
namespace mk {
struct TrItem { const float* src; int ldn, k0, n0; bf16* dst; int ldk, drow; const float* kscale; bool nt; float fp8 = 0.f; };
__device__ __forceinline__ void tr_load(const TrItem& it, f32x4 (&v)[16], int lane) {
    const float* sp = it.src + (size_t)(it.k0 + (lane >> 4)) * it.ldn + it.n0 + 4 * (lane & 15);
#pragma unroll
    for (int i = 0; i < 16; ++i) v[i] = *(const f32x4*)(sp + (size_t)(4 * i) * it.ldn);
}
__device__ __forceinline__ void tr_store(const TrItem& it, const f32x4 (&v)[16], LAS float* scr, int lane) {
#pragma unroll
    for (int i = 0; i < 16; ++i) {
        const int kk = (lane >> 4) + 4 * i;
        f32x4 x = v[i];
        if (it.kscale) x = x * it.kscale[it.k0 + kk];
        if (it.fp8 != 0.f) x = x * it.fp8;
        LAS float* d = scr + kk * 65 + 4 * (lane & 15);
        d[0] = x.x; d[1] = x.y; d[2] = x.z; d[3] = x.w;
    }
    asm volatile("s_waitcnt lgkmcnt(0)" ::: "memory");
    if (it.fp8 != 0.f) {
#pragma unroll
        for (int j = 0; j < 4; ++j) {
            const int q = lane + 64 * j, n = q >> 2, c = q & 3;
            const LAS float* s = scr + (16 * c) * 65 + n;
            v4u o; o.x = pk4_fp8(s[0], s[65], s[2 * 65], s[3 * 65]); o.y = pk4_fp8(s[4 * 65], s[5 * 65], s[6 * 65], s[7 * 65]); o.z = pk4_fp8(s[8 * 65], s[9 * 65], s[10 * 65], s[11 * 65]); o.w = pk4_fp8(s[12 * 65], s[13 * 65], s[14 * 65], s[15 * 65]);
            __builtin_nontemporal_store(o, (v4u*)((unsigned char*)it.dst + (size_t)(it.drow + n) * it.ldk + it.k0 + 16 * c));
        }
        asm volatile("s_waitcnt lgkmcnt(0)" ::: "memory");
        return;
    }
#pragma unroll
    for (int j = 0; j < 8; ++j) {
        const int q = lane + 64 * j, n = q >> 3, c = q & 7;
        const LAS float* s = scr + (8 * c) * 65 + n;
        v4u o; o.x = pk2(s[0], s[65]); o.y = pk2(s[2 * 65], s[3 * 65]); o.z = pk2(s[4 * 65], s[5 * 65]); o.w = pk2(s[6 * 65], s[7 * 65]);
        if (it.nt) __builtin_nontemporal_store(o, (v4u*)(it.dst + (size_t)(it.drow + n) * it.ldk + it.k0 + 8 * c)); else *(v4u*)(it.dst + (size_t)(it.drow + n) * it.ldk + it.k0 + 8 * c) = o;
    }
    asm volatile("s_waitcnt lgkmcnt(0)" ::: "memory");
}
template <class Make> __device__ __forceinline__ void tr_run(int first, int stride, int n_items, const Make& make, LAS float* scr, int lane) {
    if (first >= n_items) return;
    f32x4 va[16], vb[16];
    TrItem ia = make(first), ib = ia;
    tr_load(ia, va, lane);
    for (int r = first; r < n_items; r += 2 * stride) {
        const bool hb = r + stride < n_items;
        if (hb) { ib = make(r + stride); tr_load(ib, vb, lane); }
        tr_store(ia, va, scr, lane);
        if (!hb) break;
        const bool ha = r + 2 * stride < n_items;
        if (ha) { ia = make(r + 2 * stride); tr_load(ia, va, lane); }
        tr_store(ib, vb, scr, lane);
        if (!ha) break;
    }
}
struct TrMat { const float* src; int K, N; bf16* dst; int ldk, row_off; const float* kscale;
    __device__ __forceinline__ TrItem operator()(int r) const { const int nnb = N / 64, kb = r / nnb, nb = r % nnb; return TrItem{src, N, 64 * kb, 64 * nb, dst, ldk, row_off + 64 * nb, kscale, false}; } };
__device__ __forceinline__ void transpose_matrix(int& it, int gw, int NGW, const float* src, int K, int N, bf16* dst, int ldk, int row_off, const float* kscale, LAS float* scr, int lane) {
    const int n_items = (K / 64) * (N / 64);
    int first = gw - (it % NGW); if (first < 0) first += NGW;
    tr_run(first, NGW, n_items, TrMat{src, K, N, dst, ldk, row_off, kscale}, scr, lane);
    it += n_items;
}
__device__ __forceinline__ void norm_row_bf16(const float* __restrict__ xrow, const float* __restrict__ g, bf16* __restrict__ orow, int lane) {
    const f32x4* xr = (const f32x4*)xrow + lane;
    f32x4 v[4]; float s = 0.f;
#pragma unroll
    for (int j = 0; j < 4; ++j) { v[j] = xr[64 * j]; s += (v[j].x * v[j].x + v[j].y * v[j].y) + (v[j].z * v[j].z + v[j].w * v[j].w); }
    const float rstd = rsqrtf(wave_sum(s) * (1.f / 1024.f) + EPS);
    v2u* o8 = (v2u*)orow + lane;
#pragma unroll
    for (int j = 0; j < 4; ++j) { const f32x4 gg = ((const f32x4*)g)[lane + 64 * j]; v2u w; w.x = pk2(v[j].x * rstd * gg.x, v[j].y * rstd * gg.y); w.y = pk2(v[j].z * rstd * gg.z, v[j].w * rstd * gg.w); o8[64 * j] = w; }
}
__device__ __forceinline__ int rel_bucket(int n) {
    if (n < 16) return n;
    const int large = 16 + (int)(logf((float)n / 16.0f) / 2.0794415416798357f * 16.0f);
    return large < 31 ? large : 31;
}

__device__ __forceinline__ void phase_prologue(PPtr p, LAS unsigned char* lds, int vcu, int G, const int tid) {
    const int lane = tid & 63, wave = tid >> 6;
    const int gw = vcu * NWAVES + wave, NGW = G * NWAVES;
    LAS float* scr = (LAS float*)(lds + wave * 16640);
    unsigned char* ws = p->ws;
    int it = 0;
    bf16* wcat = (bf16*)(ws + W_CAT);
    transpose_matrix(it, gw, NGW, p->w_in, D, INW, wcat, D, 0, nullptr, scr, lane);
    transpose_matrix(it, gw, NGW, p->w_gate, D, 2048, wcat, D, INW, nullptr, scr, lane);
    transpose_matrix(it, gw, NGW, p->w_branch_a, D, D, (bf16*)(ws + W_A), D, 0, nullptr, scr, lane);
    transpose_matrix(it, gw, NGW, p->w_branch_b, D, D, (bf16*)(ws + W_B), D, 0, nullptr, scr, lane);
    transpose_matrix(it, gw, NGW, p->w_o, D, D, (bf16*)(ws + W_O), D, 0, nullptr, scr, lane);
    transpose_matrix(it, gw, NGW, p->w_xq, D, XW, (bf16*)(ws + W_XQ), D, 0, p->norm_x, scr, lane);
    transpose_matrix(it, gw, NGW, p->w_xkv, D, 1024, (bf16*)(ws + W_XKV), D, 0, nullptr, scr, lane);
    transpose_matrix(it, gw, NGW, p->w_xo, XW, D, (bf16*)(ws + W_XO), XW, 0, nullptr, scr, lane);
    bf16* xn = (bf16*)((unsigned char*)p->out + OUT_XN); bf16* memn = (bf16*)((unsigned char*)p->out + OUT_MEMN);
    for (int m = gw; m < T; m += NGW) norm_row_bf16(p->x + (size_t)m * D, p->norm_mix, xn + (size_t)m * D, lane);
    for (int m = gw; m < NB_ * MEM; m += NGW) norm_row_bf16(p->mem + (size_t)m * D, p->norm_mem, memn + (size_t)m * D, lane);
    const int gt = vcu * NTHREADS + tid, NGT = G * NTHREADS;
    {
        bf16* wr = (bf16*)(ws + W_R);
        for (int i = gt; i < 256 * 1024; i += NGT) { const int n = i >> 10, k = i & 1023; float v = 0.f;
            if (n < 8) v = p->w_rg[k * 8 + n] * p->norm_ffn[k]; else if (n < 72) v = p->w_re[k * 64 + (n - 8)] * p->norm_ffn[k];
            wr[i] = (bf16)f2bf(v); }
    }
    {
        bf16* wsp = (bf16*)(ws + WS_WSP);
        for (int i = gt; i < 8 * 128 * 128; i += NGT) { const int t = (i >> 7) & 127, s = i & 127; wsp[i] = (bf16)f2bf(s <= t ? p->w_spatial[i] : 0.f); }
    }
    {
        float* bt = (float*)(ws + WS_BTAB);
        for (int i = gt; i < 8 * 128; i += NGT) { const int h = i >> 7, dist = i & 127; bt[i] = p->rel_bias[rel_bucket(dist) * H + h] * 11.313708498984761f; }
    }
    {   int* ctl = (int*)(ws + WS_CTL); for (int i = gt; i < 1024; i += NGT) ctl[i] = 0; }
}

struct TrGU { const float* wg; const float* wu; unsigned char* dst; const float* ns;
    __device__ __forceinline__ TrItem operator()(int r) const { const int nb = r & 7, kb = (r >> 3) & 15, which = (r >> 7) & 1, e = r >> 8;
        const float* base = (const float*)((uintptr_t)wg + (uintptr_t)which * ((uintptr_t)wu - (uintptr_t)wg));
        return TrItem{base + (size_t)e * D * EH, EH, 64 * kb, 64 * nb, (bf16*)(dst + (size_t)e * 1024 * D), D, (nb >> 1) * 256 + which * 128 + (nb & 1) * 64, ns, true, WGU_SCALE}; } };
struct TrD { const float* wd; unsigned char* dst;
    __device__ __forceinline__ TrItem operator()(int r) const { const int nb = r & 15, kb = (r >> 4) & 7, e = r >> 7;
        return TrItem{wd + (size_t)e * EH * D, D, 64 * kb, 64 * nb, (bf16*)(dst + (size_t)e * D * EH), EH, 64 * nb, nullptr, true, WD_SCALE}; } };
constexpr int WD_G1 = 4096, WD_EARLY = 2560;
__device__ __forceinline__ void phase_convert_experts(PPtr p, LAS unsigned char* lds, int vcu, int G, int part, const int tid, int wg0 = 0) {
    const int lane = tid & 63, wave = tid >> 6;
    const int gw = vcu * NWAVES + wave, NGW = G * NWAVES;
    LAS float* scr = (LAS float*)(lds + wave * 16640);
    unsigned char* wd8 = (unsigned char*)p->out + OUT_WD;
    if (part == 0) tr_run(gw, NGW, NE * 2 * 16 * 8, TrGU{p->w_e_gate, p->w_e_up, p->ws + WS_WGU, p->norm_ffn}, scr, lane);
    else if (part == 1) tr_run(WD_G1 + WD_EARLY + gw, NGW, NE * 8 * 16, TrD{p->w_e_down, wd8}, scr, lane);
    else { const int bx = blockIdx.x, lo = part == 3 ? 0 : WD_G1, hi = part == 3 ? WD_G1 : WD_G1 + WD_EARLY;
        if (bx >= wg0) tr_run(lo + (bx - wg0) * NWAVES + wave, (G - wg0) * NWAVES, hi, TrD{p->w_e_down, wd8}, scr, lane); }
}
}
namespace mk {
using pg8::Unit;
typedef const f32x4 (&AccRef)[2][2][4][2];

__device__ __forceinline__ void tile_order(int L, int nM, int nN, int& pm, int& pn) {
    const int nwg = nM * nN; int wgid = L;
    { const int q = nwg / 8, r = nwg % 8, xcd = wgid % 8, off = wgid / 8; wgid = (xcd < r ? xcd * (q + 1) : r * (q + 1) + (xcd - r) * q) + off; }
    const int nig = 8 * nN, gid = wgid / nig, fm = gid * 8, gsz = (nM - fm) < 8 ? (nM - fm) : 8;
    pm = fm + ((wgid % nig) % gsz); pn = (wgid % nig) / gsz;
}
struct SchedPlain {
    const char* A; const char* B; int nM, nN, G, c; size_t tstep;
    __device__ __forceinline__ bool next(int i, Unit& u) const {
        const long L = (long)i * G + c; if (L >= (long)nM * nN) return false;
        tile_order((int)L, nM, nN, u.pm, u.pn); u.A = A + (size_t)u.pm * tstep; u.B = B + (size_t)u.pn * tstep; u.aux = 0; return true; }
    __device__ __forceinline__ void a_ready(const Unit&) const {}
    __device__ __forceinline__ void done(const Unit&) const {}
};
struct SchedG1 {
    const char *A, *B, *A2, *B2; int G, c;
    __device__ __forceinline__ bool next(int i, Unit& u) const {
        const long L = (long)i * G + c; constexpr int N1 = 128 * 28; constexpr size_t ts = (size_t)256 * 1024 * 2;
        if (L < N1) { tile_order((int)L, 128, 28, u.pm, u.pn); u.A = A + (size_t)u.pm * ts; u.B = B + (size_t)u.pn * ts; u.aux = 0; return true; }
        if (L < N1 + 32) { const int l = (int)L - N1; u.pm = l >> 2; u.pn = l & 3; u.A = A2 + (size_t)u.pm * ts; u.B = B2 + (size_t)u.pn * ts; u.aux = 1; return true; }
        return false; }
    __device__ __forceinline__ void a_ready(const Unit&) const {}
    __device__ __forceinline__ void done(const Unit&) const {}
};
struct SchedG2 {
    const char *A0, *B0, *A1, *B1; int G, c;
    __device__ __forceinline__ bool next(int i, Unit& u) const {
        const int tile_i = i >> 1, pass = i & 1; const long L = (long)tile_i * G + c; if (L >= 128 * 4) return false;
        constexpr size_t ts = (size_t)256 * 1024 * 2;
        tile_order((int)L, 128, 4, u.pm, u.pn); u.A = (pass ? A1 : A0) + (size_t)u.pm * ts; u.B = (pass ? B1 : B0) + (size_t)u.pn * ts; u.aux = pass; return true; }
    __device__ __forceinline__ void a_ready(const Unit&) const {}
    __device__ __forceinline__ void done(const Unit&) const {}
};

#define EPI_ROWS(ai, m) (row0 + (ai) * 128 + (m) * 16)
__device__ __forceinline__ v4u pack8f(f32x4 a, f32x4 b) { v4u w; w.x = pk2(a[0], a[1]); w.y = pk2(a[2], a[3]); w.z = pk2(b[0], b[1]); w.w = pk2(b[2], b[3]); return w; }

static_assert(WS_U == 0 && WS_GV == 64 * MiB && WS_Q == 128 * MiB && WS_V == 192 * MiB && WS_K == 256 * MiB, "EpiG1 output offsets");
template <int PLAINP = 0> struct EpiG1T {
    static constexpr bool PERM = true, AFTER_DRAIN = false, CHAIN = false;
    unsigned char* ws; const float* b_gate;
    __device__ __forceinline__ void operator()(AccRef acc, const Unit& u, int wr, int wc, int fr, int fq) const {
        if (PLAINP == 2) {
#pragma unroll
            for (int ai = 0; ai < 2; ++ai)
#pragma unroll
                for (int bj = 0; bj < 2; ++bj)
#pragma unroll
                    for (int m = 0; m < 4; ++m)
#pragma unroll
                        for (int n = 0; n < 2; ++n) asm volatile("" :: "v"(acc[ai][bj][m][n]));
            return; }
        const int row0 = u.pm * 256 + wr * 64 + fr, cl = wc * 32 + 8 * fq;
        if (u.aux == 1) {
#pragma unroll
            for (int ai = 0; ai < 2; ++ai)
#pragma unroll
                for (int m = 0; m < 4; ++m)
#pragma unroll
                    for (int bj = 0; bj < 2; ++bj) __builtin_nontemporal_store(pack8f(acc[ai][bj][m][0], acc[ai][bj][m][1]), (v4u*)((bf16*)(ws + WS_KVM) + (size_t)EPI_ROWS(ai, m) * 1024 + u.pn * 256 + bj * 128 + cl));
            return;
        }
        const int pn = PLAINP ? 8 + (u.pn % 4) : u.pn;
        if (pn >= 4 && pn < 8) {
            bf16* O = (bf16*)(ws + WS_GV); const int c0 = (pn & 3) * 256 + cl; const bool stats = true;
            float* vstat = (float*)(ws + WS_VSTAT);
#pragma unroll
            for (int ai = 0; ai < 2; ++ai)
#pragma unroll
                for (int m = 0; m < 4; ++m) { float ss = 0.f;
#pragma unroll
                    for (int bj = 0; bj < 2; ++bj) { f32x4 a = acc[ai][bj][m][0], b = acc[ai][bj][m][1];
#pragma unroll
                        for (int j = 0; j < 4; ++j) { a[j] = gelu_tanh(a[j]); b[j] = gelu_tanh(b[j]); ss += a[j] * a[j] + b[j] * b[j]; }
                        __builtin_nontemporal_store(pack8f(a, b), (v4u*)(O + (size_t)EPI_ROWS(ai, m) * 1024 + c0 + bj * 128)); }
                    if (stats) { ss += __shfl_xor(ss, 16); ss += __shfl_xor(ss, 32); if (fq == 0) vstat[(size_t)EPI_ROWS(ai, m) * 16 + (pn - 4) * 4 + wc] = ss; } }
        } else if (pn < 20) {
            const int reg = pn >> 2;
            bf16* O = (bf16*)(ws + (size_t)(reg == 0 ? 0 : reg == 2 ? 2 : reg == 3 ? 4 : 3) * (64 * MiB)); const int c0 = (pn & 3) * 256 + cl;
            float* kpart = (float*)(ws + WS_KPART);
#pragma unroll
            for (int ai = 0; ai < 2; ++ai)
#pragma unroll
                for (int m = 0; m < 4; ++m)
#pragma unroll
                    for (int bj = 0; bj < 2; ++bj) __builtin_nontemporal_store(pack8f(acc[ai][bj][m][0], acc[ai][bj][m][1]), (v4u*)(O + (size_t)EPI_ROWS(ai, m) * 1024 + c0 + bj * 128));
            if (pn >= 12 && pn < 16) {
#pragma unroll
                for (int bj = 0; bj < 2; ++bj)
#pragma unroll
                    for (int n = 0; n < 2; ++n) { f32x4 s = acc[0][bj][0][n];
#pragma unroll
                        for (int m = 1; m < 4; ++m) s = s + acc[0][bj][m][n];
#pragma unroll
                        for (int m = 0; m < 4; ++m) s = s + acc[1][bj][m][n];
#pragma unroll
                        for (int j = 0; j < 4; ++j) { float v = s[j]; v += __shfl_xor(v, 1); v += __shfl_xor(v, 2); v += __shfl_xor(v, 4); v += __shfl_xor(v, 8); s[j] = v; }
                        if (fr == 0) *(f32x4*)(kpart + ((size_t)u.pm * 2 + wr) * 1024 + c0 + bj * 128 + 4 * n) = s; }
            }
        } else {
            const int c0 = (pn - 20) * 256 + cl;
#pragma unroll
            for (int bj = 0; bj < 2; ++bj) { const f32x4 b0 = *(const f32x4*)(b_gate + c0 + bj * 128), b1 = *(const f32x4*)(b_gate + c0 + bj * 128 + 4);
#pragma unroll
                for (int ai = 0; ai < 2; ++ai)
#pragma unroll
                    for (int m = 0; m < 4; ++m) { f32x4 a = acc[ai][bj][m][0] + b0, b = acc[ai][bj][m][1] + b1;
#pragma unroll
                        for (int j = 0; j < 4; ++j) { a[j] = sigmoid_f(a[j]); b[j] = sigmoid_f(b[j]); }
                        v2u w8; w8.x = pk4_u8(a); w8.y = pk4_u8(b);
                        __builtin_nontemporal_store(w8, (v2u*)(ws + WS_G + (size_t)EPI_ROWS(ai, m) * 2048 + c0 + bj * 128)); } }
        }
    }
};
typedef EpiG1T<0> EpiG1;
struct EpiG2 {
    static constexpr bool PERM = true, AFTER_DRAIN = false, CHAIN = true;
    const unsigned char* Gt; bf16* MG;
    __device__ __forceinline__ bool mid(f32x4 (&acc)[2][2][4][2], const Unit& u, int wr, int wc, int fr, int fq) const {
        if (u.aux != 0) return false;
        const int row0 = u.pm * 256 + wr * 64 + fr, c0 = u.pn * 256 + wc * 32 + 8 * fq;
#pragma unroll
        for (int ai = 0; ai < 2; ++ai) {
            v2u g0[4][2], g1[4][2];
#pragma unroll
            for (int m = 0; m < 4; ++m)
#pragma unroll
                for (int bj = 0; bj < 2; ++bj) { const size_t r = (size_t)EPI_ROWS(ai, m); g0[m][bj] = *(const v2u*)(Gt + r * 2048 + c0 + bj * 128); g1[m][bj] = *(const v2u*)(Gt + r * 2048 + 1024 + c0 + bj * 128); }
#pragma unroll
            for (int m = 0; m < 4; ++m)
#pragma unroll
                for (int bj = 0; bj < 2; ++bj) {
#pragma unroll
                    for (int n = 0; n < 2; ++n) { const f32x4 q0 = unpk4_u8(n ? g0[m][bj].y : g0[m][bj].x), q1 = unpk4_u8(n ? g1[m][bj].y : g1[m][bj].x);
#pragma unroll
                        for (int j = 0; j < 4; ++j) acc[ai][bj][m][n][j] *= q0[j] * fast_rcp(fmaxf(q1[j], 1e-30f)); } }
        }
        return true;
    }
    __device__ __forceinline__ void operator()(AccRef acc, const Unit& u, int wr, int wc, int fr, int fq) const {
        const int row0 = u.pm * 256 + wr * 64 + fr, c0 = u.pn * 256 + wc * 32 + 8 * fq;
        v2u gg[2][4][2];
#pragma unroll
        for (int ai = 0; ai < 2; ++ai)
#pragma unroll
            for (int m = 0; m < 4; ++m)
#pragma unroll
                for (int bj = 0; bj < 2; ++bj) gg[ai][m][bj] = *(const v2u*)(Gt + (size_t)EPI_ROWS(ai, m) * 2048 + 1024 + c0 + bj * 128);
#pragma unroll
        for (int ai = 0; ai < 2; ++ai)
#pragma unroll
            for (int m = 0; m < 4; ++m)
#pragma unroll
                for (int bj = 0; bj < 2; ++bj) { const size_t r = (size_t)EPI_ROWS(ai, m); const v2u g = gg[ai][m][bj];
                    const f32x4 qa = unpk4_u8(g.x), qb = unpk4_u8(g.y);
                    f32x4 a = acc[ai][bj][m][0], b = acc[ai][bj][m][1];
#pragma unroll
                    for (int j = 0; j < 4; ++j) { a[j] *= fmaxf(qa[j], 1e-30f) * (1.0f / 255.0f); b[j] *= fmaxf(qb[j], 1e-30f) * (1.0f / 255.0f); }
                    *(v4u*)(MG + r * 1024 + c0 + bj * 128) = pack8f(a, b); }
    }
};
template <bool BASE_F32, bool OUT8 = false> struct EpiRes {
    static constexpr bool PERM = true, AFTER_DRAIN = false, CHAIN = false;
    const float* basef; bf16* HB; float* stat; bf16* HO; unsigned char* X8;
    __device__ __forceinline__ void operator()(AccRef acc, const Unit& u, int wr, int wc, int fr, int fq) const {
        const int row0 = u.pm * 256 + wr * 64 + fr, c0 = u.pn * 256 + wc * 32 + 8 * fq;
#pragma unroll
        for (int ai = 0; ai < 2; ++ai) {
            f32x4 ba[4][2][2]; v4u bw[4][2];
#pragma unroll
            for (int m = 0; m < 4; ++m)
#pragma unroll
                for (int bj = 0; bj < 2; ++bj) { const size_t o = (size_t)EPI_ROWS(ai, m) * 1024 + c0 + bj * 128;
                    if constexpr (BASE_F32) { ba[m][bj][0] = *(const f32x4*)(basef + o); ba[m][bj][1] = *(const f32x4*)(basef + o + 4); } else { bw[m][bj] = *(const v4u*)(HB + o); } }
#pragma unroll
            for (int m = 0; m < 4; ++m) { const size_t r = (size_t)EPI_ROWS(ai, m); float ss = 0.f;
#pragma unroll
                for (int bj = 0; bj < 2; ++bj) { const size_t o = r * 1024 + c0 + bj * 128;
                    f32x4 a, b;
                    if constexpr (BASE_F32) { a = ba[m][bj][0]; b = ba[m][bj][1]; }
                    else { const v4u w = bw[m][bj]; a = (f32x4){bflo(w.x), bfhi(w.x), bflo(w.y), bfhi(w.y)}; b = (f32x4){bflo(w.z), bfhi(w.z), bflo(w.w), bfhi(w.w)}; }
                    a = a + acc[ai][bj][m][0]; b = b + acc[ai][bj][m][1];
                    *(v4u*)(HO + o) = pack8f(a, b);
                    if constexpr (OUT8) { v2u w8; w8.x = pk4_fp8(a[0], a[1], a[2], a[3]); w8.y = pk4_fp8(b[0], b[1], b[2], b[3]); *(v2u*)(X8 + o) = w8; }
                    ss += (a[0] * a[0] + a[1] * a[1]) + (a[2] * a[2] + a[3] * a[3]) + (b[0] * b[0] + b[1] * b[1]) + (b[2] * b[2] + b[3] * b[3]); }
                ss += __shfl_xor(ss, 16); ss += __shfl_xor(ss, 32); if (fq == 0) stat[r * 16 + u.pn * 4 + wc] = ss; }
        }
    }
};
__device__ __forceinline__ float row_rstd(const float* stat, size_t r) {
    const f32x4* s = (const f32x4*)(stat + r * 16); const f32x4 a = s[0], b = s[1], c = s[2], d = s[3];
    const float t = ((a[0] + a[1]) + (a[2] + a[3])) + ((b[0] + b[1]) + (b[2] + b[3])) + ((c[0] + c[1]) + (c[2] + c[3])) + ((d[0] + d[1]) + (d[2] + d[3]));
    return rsqrtf(t * (1.0f / 1024.0f) + EPS);
}
struct EpiScaleBf16 {
    static constexpr bool PERM = true, AFTER_DRAIN = false, CHAIN = false;
    bf16* O; int ldo; const float* stat;
    __device__ __forceinline__ void operator()(AccRef acc, const Unit& u, int wr, int wc, int fr, int fq) const {
        const int row0 = u.pm * 256 + wr * 64 + fr, c0 = u.pn * 256 + wc * 32 + 8 * fq;
        float rsv[8];
#pragma unroll
        for (int k = 0; k < 8; ++k) rsv[k] = row_rstd(stat, (size_t)EPI_ROWS(k >> 2, k & 3));
#pragma unroll
        for (int ai = 0; ai < 2; ++ai)
#pragma unroll
            for (int m = 0; m < 4; ++m) { const size_t r = (size_t)EPI_ROWS(ai, m); const float rs = rsv[ai * 4 + m];
#pragma unroll
                for (int bj = 0; bj < 2; ++bj) *(v4u*)(O + r * ldo + c0 + bj * 128) = pack8f(acc[ai][bj][m][0] * rs, acc[ai][bj][m][1] * rs); }
    }
};
struct EpiRouter {
    static constexpr bool PERM = true, AFTER_DRAIN = false, CHAIN = false;
    float* RL; const float* stat;
    __device__ __forceinline__ void operator()(AccRef acc, const Unit& u, int wr, int wc, int fr, int fq) const {
        const int row0 = u.pm * 256 + wr * 64 + fr, c0 = wc * 32 + 8 * fq;
        float rsv[8];
#pragma unroll
        for (int k = 0; k < 8; ++k) rsv[k] = row_rstd(stat, (size_t)EPI_ROWS(k >> 2, k & 3));
#pragma unroll
        for (int ai = 0; ai < 2; ++ai)
#pragma unroll
            for (int m = 0; m < 4; ++m) { const size_t r = (size_t)EPI_ROWS(ai, m); const float rs = rsv[ai * 4 + m];
                *(f32x4*)(RL + r * 128 + c0) = acc[ai][0][m][0] * rs; *(f32x4*)(RL + r * 128 + c0 + 4) = acc[ai][0][m][1] * rs; }
    }
};
}
namespace mk {
typedef float f32x16 __attribute__((ext_vector_type(16)));
template <int NT> __device__ __forceinline__ void wave_mma_rows(const bf16* __restrict__ A, int lda, const bf16* __restrict__ Bt, int ldb, int K, f32x16 (&acc)[NT], int lane) {
    const int r32 = lane & 31, hi = lane >> 5;
    const bf16* ap = A + (size_t)r32 * lda + hi * 8; const bf16* bp = Bt + (size_t)r32 * ldb + hi * 8;
#pragma unroll
    for (int j = 0; j < NT; ++j)
#pragma unroll
        for (int r = 0; r < 16; ++r) acc[j][r] = 0.f;
#pragma unroll 16
    for (int k = 0; k < K; k += 16) {
        const bf16x8 a = *(const bf16x8*)(ap + k);
#pragma unroll
        for (int j = 0; j < NT; ++j) { const bf16x8 b = *(const bf16x8*)(bp + (size_t)(32 * j) * ldb + k); acc[j] = __builtin_amdgcn_mfma_f32_32x32x16_bf16(b, a, acc[j], 0, 0, 0); }
    }
}
__device__ __forceinline__ void phase_memkv(PPtr p, int vcu, int G, const int tid) {
    const int lane = tid & 63, wave = tid >> 6, r32 = lane & 31, hi = lane >> 5; const int gw = vcu * NWAVES + wave, NGW = G * NWAVES;
    const bf16* memn = (const bf16*)((const unsigned char*)p->out + OUT_MEMN); const bf16* w = (const bf16*)(p->ws + W_XKV); bf16* kvm = (bf16*)(p->ws + WS_KVM);
    for (int it = gw; it < 64 * 32; it += NGW) {
        const int rg = it >> 5, cg = it & 31;
        f32x16 acc[1];
        wave_mma_rows<1>(memn + (size_t)(32 * rg) * 1024, 1024, w + (size_t)(32 * cg) * 1024, 1024, 1024, acc, lane);
#pragma unroll
        for (int q = 0; q < 4; ++q) { v2u o; o.x = pk2(acc[0][4 * q], acc[0][4 * q + 1]); o.y = pk2(acc[0][4 * q + 2], acc[0][4 * q + 3]);
            *(v2u*)(kvm + (size_t)(32 * rg + r32) * 1024 + 32 * cg + 8 * q + 4 * hi) = o; }
    }
}
}
namespace att {
using bf16 = __hip_bfloat16;
constexpr int D = 128;
constexpr float THR = 8.f;
constexpr bool WSKIP = false;
constexpr float SCALE = 0.08838834764831845f;
constexpr int NW = 8, QBLK = 32, KVBLK = 64, QB = NW * QBLK;
constexpr int SHM_V = KVBLK * D * 2, SHM_K = KVBLK * D * 2;
constexpr int LDS_BYTES = 2 * SHM_V + 2 * SHM_K + NW * 64 * 4;
typedef short bf16x8 __attribute__((ext_vector_type(8)));
typedef short s16x4 __attribute__((ext_vector_type(4)));
typedef float f32x16 __attribute__((ext_vector_type(16)));
typedef float f32x4 __attribute__((ext_vector_type(4)));
typedef unsigned u32x4 __attribute__((ext_vector_type(4)));
template <class A, class Bt> struct same_t { static constexpr bool v = false; };
template <class A> struct same_t<A, A> { static constexpr bool v = true; };
#define KSWZ(row, colB) ((row) * 256 + ((colB) ^ (((row) & 7) << 4)))
#define SBAR() __builtin_amdgcn_sched_barrier(0)
__device__ __forceinline__ int v_st(int k, int c) { const int kk = (k & ~0xC) | ((k & 4) << 1) | ((k & 8) >> 1); return ((kk >> 3) * 4 + (c >> 5)) * 512 + ((kk & 7) * 32 + (c & 31)) * 2; }
__device__ __forceinline__ int v_rd_base(int lane) { return ((lane & 3) << 3) | (((lane >> 2) & 3) << 6) | (((lane >> 4) & 1) << 5) | (((lane >> 5) & 1) << 8); }
constexpr int v_rd_off(int d0, int ks, int half) { return d0 * 512 + ks * 4096 + half * 2048; }
__device__ __forceinline__ int crow(int r, int hi) { return (r & 3) + 8 * (r >> 2) + 4 * hi; }
__device__ __forceinline__ unsigned cvtpk(float lo, float hi) {
    unsigned r; asm volatile("v_cvt_pk_bf16_f32 %0, %1, %2" : "=v"(r) : "v"(lo), "v"(hi)); return r;
}
__device__ __forceinline__ bf16x8 pack8(f32x4 a, f32x4 b) {
    u32x4 w = {cvtpk(a[0], a[1]), cvtpk(a[2], a[3]), cvtpk(b[0], b[1]), cvtpk(b[2], b[3])};
    return *reinterpret_cast<bf16x8*>(&w);
}
template <class T> __device__ __forceinline__ bf16x8 load8(const T* p) {
    if constexpr (same_t<T, float>::v) { return pack8(*(const f32x4*)p, *(const f32x4*)(p + 4)); }
    else { return *reinterpret_cast<const bf16x8*>(p); }
}
__device__ __forceinline__ void mask_tile(f32x16& p0, f32x16& p1, int dq, unsigned W) {
    const float NEG = -__builtin_inff();
#pragma unroll
    for (int r = 0; r < 16; ++r) {
        const int c = (r & 3) + 8 * (r >> 2);
        if ((unsigned)(dq - c) >= W) p0[r] = NEG;
        if ((unsigned)(dq - c - 32) >= W) p1[r] = NEG;
    }
}
__device__ __forceinline__ void moba_mask_tile(f32x16& p0, f32x16& p1, int dq, const float* bt) {
    const float NEG = -__builtin_inff();
#pragma unroll
    for (int r = 0; r < 16; ++r) {
        const int c = (r & 3) + 8 * (r >> 2);
        const int d0 = dq - c, d1 = dq - c - 32;
        const float b0 = bt[d0 < 0 ? 0 : (d0 > 127 ? 127 : d0)], b1 = bt[d1 < 0 ? 0 : (d1 > 127 ? 127 : d1)];
        p0[r] = d0 < 0 ? NEG : p0[r] + b0;
        p1[r] = d1 < 0 ? NEG : p1[r] + b1;
        if ((r & 3) == 3) asm volatile("" ::: "memory");
    }
}
__device__ __forceinline__ void partialSM(f32x16& p0, f32x16& p1, float& m_reg, float& mn, float& alpha, float cadd = 0.f) {
    float pmax = p0[0]; for (int r = 1; r < 16; ++r) pmax = fmaxf(pmax, p0[r]); for (int r = 0; r < 16; ++r) pmax = fmaxf(pmax, p1[r]);
    { auto rr = __builtin_amdgcn_permlane32_swap(__float_as_uint(pmax), __float_as_uint(pmax), false, false);
      pmax = fmaxf(__uint_as_float(rr[0]), __uint_as_float(rr[1])); }
    pmax += cadd;
    constexpr float C2 = 1.4426950408889634f * SCALE;
    if (__builtin_expect(__all((pmax - m_reg) * SCALE <= THR), 1)) { mn = m_reg; alpha = 1.f; }
    else { mn = fmaxf(m_reg, pmax); alpha = __builtin_amdgcn_exp2f((m_reg - mn) * C2); m_reg = mn; }
    const float mnL = (cadd - mn) * C2;
    for (int r = 0; r < 16; ++r) p0[r] = fmaf(p0[r], C2, mnL); for (int r = 0; r < 16; ++r) p1[r] = fmaf(p1[r], C2, mnL);
    for (int r = 0; r < 16; ++r) p0[r] = __builtin_amdgcn_exp2f(p0[r]);
}
__device__ __forceinline__ void finishSM(f32x16& p0, f32x16& p1, float alpha, float& l_reg, bf16x8& pa0, bf16x8& pa1, bf16x8& pa2, bf16x8& pa3) {
    for (int r = 0; r < 16; ++r) p1[r] = __builtin_amdgcn_exp2f(p1[r]);
    float ps = 0; for (int r = 0; r < 16; ++r) ps += p0[r]; for (int r = 0; r < 16; ++r) ps += p1[r];
    { auto rr = __builtin_amdgcn_permlane32_swap(__float_as_uint(ps), __float_as_uint(ps), false, false);
      ps = __uint_as_float(rr[0]) + __uint_as_float(rr[1]); }
    l_reg = l_reg * alpha + ps;
#define PK4(P, B_, OUT) do { unsigned a0 = cvtpk(P[B_+0], P[B_+1]), a1 = cvtpk(P[B_+2], P[B_+3]);                          \
        unsigned b0 = cvtpk(P[B_+4], P[B_+5]), b1 = cvtpk(P[B_+6], P[B_+7]);                                             \
        auto r0 = __builtin_amdgcn_permlane32_swap(a0, b0, false, false); auto r1 = __builtin_amdgcn_permlane32_swap(a1, b1, false, false); \
        u32x4 w = {r0[0], r1[0], r0[1], r1[1]}; OUT = *reinterpret_cast<bf16x8*>(&w); } while (0)
    PK4(p0, 0, pa0); PK4(p0, 8, pa1); PK4(p1, 0, pa2); PK4(p1, 8, pa3);
#undef PK4
}
template <int KB, bool SK>
__device__ __forceinline__ void qkt(f32x16& p0, f32x16& p1, const char* K_lds, int r32, int hi, const bf16x8* qr, bool act) {
    if (SK && !act) { const float NEG = -__builtin_inff();
#pragma unroll
        for (int r = 0; r < 16; ++r) { p0[r] = NEG; p1[r] = NEG; } return; }
    p0 = f32x16{}; p1 = f32x16{};
    const char* kb[4];
#pragma unroll
    for (int dd = 0; dd < 4; ++dd) kb[dd] = K_lds + KB * SHM_K + KSWZ(r32, (dd * 16 + hi * 8) * 2);
#pragma unroll
    for (int d0 = 0; d0 < 8; ++d0) { const char* a = kb[d0 & 3] + (d0 >> 2) * 128;
        bf16x8 b0 = *reinterpret_cast<const bf16x8*>(a);
        bf16x8 b1 = *reinterpret_cast<const bf16x8*>(a + 32 * 256);
        p0 = __builtin_amdgcn_mfma_f32_32x32x16_bf16(b0, qr[d0], p0, 0, 0, 0);
        p1 = __builtin_amdgcn_mfma_f32_32x32x16_bf16(b1, qr[d0], p1, 0, 0, 0); }
}
template <int VB, bool SK>
__device__ __forceinline__ void pv_tile(f32x16* o, int vb0, bf16x8 pa0, bf16x8 pa1, bf16x8 pa2, bf16x8 pa3, bool act) {
    if (SK && !act) return;
#define TRRD(dst, off) asm volatile("ds_read_b64_tr_b16 %0, %1 offset:%2" : "=&v"(dst) : "v"(vb0), "i"(off) : "memory")
#define PV_D0(d0) do { s16x4 l0, l1, l2, l3, h0, h1, h2, h3; constexpr int b_ = VB * SHM_V + v_rd_off(d0, 0, 0);     \
        TRRD(l0, b_); TRRD(h0, b_ + 2048); TRRD(l1, b_ + 4096); TRRD(h1, b_ + 6144); TRRD(l2, b_ + 8192); TRRD(h2, b_ + 10240); TRRD(l3, b_ + 12288); TRRD(h3, b_ + 14336); \
        asm volatile("s_waitcnt lgkmcnt(0)" ::: "memory"); SBAR();                 \
        o[d0] = __builtin_amdgcn_mfma_f32_32x32x16_bf16(pa0, (bf16x8){l0[0], l0[1], l0[2], l0[3], h0[0], h0[1], h0[2], h0[3]}, o[d0], 0, 0, 0);   \
        o[d0] = __builtin_amdgcn_mfma_f32_32x32x16_bf16(pa1, (bf16x8){l1[0], l1[1], l1[2], l1[3], h1[0], h1[1], h1[2], h1[3]}, o[d0], 0, 0, 0);   \
        o[d0] = __builtin_amdgcn_mfma_f32_32x32x16_bf16(pa2, (bf16x8){l2[0], l2[1], l2[2], l2[3], h2[0], h2[1], h2[2], h2[3]}, o[d0], 0, 0, 0);   \
        o[d0] = __builtin_amdgcn_mfma_f32_32x32x16_bf16(pa3, (bf16x8){l3[0], l3[1], l3[2], l3[3], h3[0], h3[1], h3[2], h3[3]}, o[d0], 0, 0, 0); } while (0)
    PV_D0(0); PV_D0(1); PV_D0(2); PV_D0(3);
#undef PV_D0
#undef TRRD
}

__device__ __forceinline__ float cinit_moba(int kb, int cur_blk, unsigned selmask, int qlo, float b31) {
    const int n = kb >> 8;
    if (n != cur_blk && !((selmask >> n) & 1u)) return -__builtin_inff();
    return (kb + KVBLK - 1 + 113 > qlo) ? 0.f : b31;
}
template <class TIn, class TOut> struct BlockRef { const TIn* Q; const TIn* K; const TIn* V; TOut* O; int P0; const float* kp; const float* btg; int h; };
template <class TIn> struct Seam {
    bf16x8 qr[8];
    bf16x8 st_v0, st_v1, st_k0, st_k1; f32x4 sf0, sf1, sf2, sf3;
    f32x4 tq[16];
};
__device__ __forceinline__ int swa_jlo(int P0, int W) { const int lowk = P0 - W + 1; return lowk > 0 ? lowk / KVBLK : 0; }
#define ROW(p, k0, rr) ((p) + (size_t)(k0) * LDKV + (unsigned)((rr) * LDKV + sc))
#define VMW() asm volatile("s_waitcnt vmcnt(0)" ::: "memory")
#define VMWN(n) asm volatile("s_waitcnt vmcnt(%0)" :: "i"(n) : "memory")
#define SLOAD_H(Kp, Vp, k0) do { S.st_v0 = load8<TIn>(ROW(Vp, k0, sr)); S.st_v1 = load8<TIn>(ROW(Vp, k0, 32 + sr));              \
                         S.st_k0 = load8<TIn>(ROW(Kp, k0, sr)); S.st_k1 = load8<TIn>(ROW(Kp, k0, 32 + sr)); } while (0)
#define SWRITE_HK(bf) do { *(bf16x8*)(K_lds + (bf) * SHM_K + kws) = S.st_k0; *(bf16x8*)(K_lds + (bf) * SHM_K + kws + 32 * 256) = S.st_k1; } while (0)
#define SWRITE_HV(bf) do { *(bf16x8*)(V_lds + (bf) * SHM_V + vst0) = S.st_v0; *(bf16x8*)(V_lds + (bf) * SHM_V + vst1) = S.st_v1; } while (0)
#define SWRITE_H(bf) do { SWRITE_HV(bf); SWRITE_HK(bf); } while (0)
#define SLOAD_F(p, k0) do { S.sf0 = *(const f32x4*)ROW(p, k0, sr); S.sf1 = *(const f32x4*)(ROW(p, k0, sr) + 4);                \
                            S.sf2 = *(const f32x4*)ROW(p, k0, 32 + sr); S.sf3 = *(const f32x4*)(ROW(p, k0, 32 + sr) + 4); } while (0)
#define SWRITE_KF(bf) do { *(bf16x8*)(K_lds + (bf) * SHM_K + kws) = pack8(S.sf0, S.sf1); *(bf16x8*)(K_lds + (bf) * SHM_K + kws + 32 * 256) = pack8(S.sf2, S.sf3); } while (0)
#define SWRITE_VF(bf) do { *(bf16x8*)(V_lds + (bf) * SHM_V + vst0) = pack8(S.sf0, S.sf1); *(bf16x8*)(V_lds + (bf) * SHM_V + vst1) = pack8(S.sf2, S.sf3); } while (0)
template <class TIn, class TOut, int MODE, int LDQ, int LDKV>
__device__ __forceinline__ void causal_swa_prime(const BlockRef<TIn, TOut>& cur, int W, char* lds, Seam<TIn>& S, const int tid) {
    constexpr bool F32 = same_t<TIn, float>::v;
    const int wid = __builtin_amdgcn_readfirstlane(tid >> 6), lane = tid & 63, r32 = lane & 31, hi = lane >> 5;
    const int sr = tid >> 4, sc = (tid & 15) * 8, kws = KSWZ(sr, sc * 2); char* K_lds = lds + 2 * SHM_V;
    const int kb0 = swa_jlo(cur.P0, W) * KVBLK;
    for (int d0 = 0; d0 < 8; ++d0) S.qr[d0] = load8<TIn>(cur.Q + (unsigned)((wid * QBLK + r32) * LDQ + d0 * 16 + hi * 8));
    if constexpr (F32) { SLOAD_F((const float*)cur.K, kb0); VMW(); SWRITE_KF(0); SBAR(); SLOAD_F((const float*)cur.V, kb0); }
    else { SLOAD_H(cur.K, cur.V, kb0); VMW(); SWRITE_HK(0); }
    __syncthreads();
}
template <class TIn, class TOut, int MODE, int LDQ, int LDKV>
__device__ __forceinline__ void causal_swa_block(const BlockRef<TIn, TOut>& cur, const BlockRef<TIn, TOut>& nxt, int skv, int W, char* lds, Seam<TIn>& S, const int tid) {
    constexpr bool F32 = same_t<TIn, float>::v;
    const int wid = __builtin_amdgcn_readfirstlane(tid >> 6), lane = tid & 63, r32 = lane & 31, hi = lane >> 5;
    const int j_lo = swa_jlo(cur.P0, W);
    int j_hi = (cur.P0 + QB - 1) / KVBLK + 1; if (j_hi > skv / KVBLK) j_hi = skv / KVBLK;
    const int NT = j_hi - j_lo;
    const int kbn = swa_jlo(nxt.P0, W) * KVBLK;
    const int qlo = cur.P0 + wid * QBLK, qm = qlo + r32 - 4 * hi;
    char* V_lds = lds; char* K_lds = lds + 2 * SHM_V;
    float* ws = (float*)(lds + 2 * SHM_V + 2 * SHM_K) + wid * 64; float* li_l = ws, * al_l = ws + 32;
    float m_reg = -1e30f, l_reg = 0; f32x16 o[4] = {};
    const int sr = tid >> 4, sc = (tid & 15) * 8, vst0 = v_st(sr, sc), vst1 = v_st(32 + sr, sc), kws = KSWZ(sr, sc * 2);
    const int vb0 = (int)(uintptr_t)V_lds + v_rd_base(lane);
    const TIn* Kh = cur.K; const TIn* Vh = cur.V;
#define RESC(a) do { if (__any((a) < 1.f)) { if (hi == 0) al_l[r32] = (a); asm volatile("s_waitcnt lgkmcnt(0)" ::: "memory");              \
                     for (int d_ = 0; d_ < 4; ++d_) for (int r = 0; r < 16; ++r) o[d_][r] *= al_l[crow(r, hi)]; } } while (0)
#define KBASE(t) ((j_lo + (t)) * KVBLK)
#define ACT(t) (KBASE(t) <= qlo + QBLK - 1 && KBASE(t) + KVBLK - 1 >= qlo - W + 1)
#define MASKT(P0_, P1_, t) do { if constexpr (MODE == 1) { const int kb_ = KBASE(t); if (kb_ + KVBLK - 1 + 113 > qlo) moba_mask_tile(P0_, P1_, qm - kb_, btab); } \
        else if constexpr (MODE == 2) { const int kb_ = KBASE(t); if (kb_ + KVBLK - 1 > qlo) mask_tile(P0_, P1_, qm - kb_, (unsigned)W); } } while (0)
    constexpr int NQL = F32 ? 16 : 8;
    constexpr bool SK = WSKIP && !F32;
#define SEAM_K0() do { VMWN(NQL); if constexpr (F32) { SWRITE_KF(0); SBAR(); SLOAD_F((const float*)nxt.V, kbn); } else { SWRITE_HK(0); } SBAR(); } while (0)
    f32x16 pA0, pA1, pB0, pB1; float mnA, mnB, alA, alB; bf16x8 pa0, pa1, pa2, pa3;
    unsigned selmask = 0xFFFFFFFFu; float b31 = 0.f; const float* btab = nullptr; const int cur_blk = cur.P0 >> 8;
    if constexpr (MODE == 1) {
        float* kms = (float*)(lds + LDS_BYTES);
        float* btl = kms + 16 * 128;
        int tq = tid; asm volatile("" : "+v"(tq));
        const int hq = (tq >> 5) & 1;
        { const int n = tq >> 5, d4 = (tq & 31) * 4;
          if (n < cur_blk) { const float* k0 = cur.kp + ((size_t)n * 2) * 1024 + cur.h * 128 + d4; const f32x4 a = *(const f32x4*)k0, b = *(const f32x4*)(k0 + 1024); *(f32x4*)(kms + n * 128 + d4) = a + b; }
          if (tq < 128) btl[tq] = cur.btg[tq]; }
        __syncthreads();
        btab = btl; b31 = __builtin_bit_cast(float, __builtin_amdgcn_readfirstlane(__builtin_bit_cast(int, btl[127])));
        if (cur_blk <= 3) selmask = (1u << cur_blk) - 1u;
        else {
            float g[15];
#pragma unroll
            for (int n = 0; n < 15; ++n) { float s = -__builtin_inff();
                if (n < cur_blk) { s = 0.f;
#pragma unroll
                    for (int d0 = 0; d0 < 8; ++d0) { const bf16x8 q = S.qr[d0]; const float* kk = kms + n * 128 + d0 * 16 + hq * 8; const f32x4 k0 = *(const f32x4*)kk, k1 = *(const f32x4*)(kk + 4);
#pragma unroll
                        for (int j = 0; j < 4; ++j) { s = fmaf(__builtin_bit_cast(float, (unsigned)(unsigned short)q[j] << 16), k0[j], s); s = fmaf(__builtin_bit_cast(float, (unsigned)(unsigned short)q[4 + j] << 16), k1[j], s); } }
                    s += __shfl_xor(s, 32); }
                g[n] = s; }
            selmask = 0u;
#pragma unroll
            for (int r = 0; r < 3; ++r) { float bv = -__builtin_inff(); int bi = 0;
#pragma unroll
                for (int n = 0; n < 15; ++n) { const bool take = !((selmask >> n) & 1u) && g[n] > bv; bv = take ? g[n] : bv; bi = take ? n : bi; }
                selmask |= 1u << bi; }
        }
    }
#define CINIT(t) (MODE == 1 ? cinit_moba(KBASE(t), cur_blk, selmask, qlo, b31) : 0.f)
    if constexpr (F32) { VMW(); SWRITE_VF(0); SBAR(); } else { SWRITE_HV(0); SBAR(); }
    if (NT > 1) { if constexpr (F32) SLOAD_F((const float*)Kh, KBASE(1)); else SLOAD_H(Kh, Vh, KBASE(1)); }
    SBAR(); qkt<0, SK>(pA0, pA1, K_lds, r32, hi, S.qr, ACT(0));
    if constexpr (F32) { if (NT > 1) { VMW(); SWRITE_KF(1); SBAR(); SLOAD_F((const float*)Vh, KBASE(1)); } }
    MASKT(pA0, pA1, 0); partialSM(pA0, pA1, m_reg, mnA, alA, CINIT(0));
    if (NT > 1) { VMW(); if constexpr (F32) { SWRITE_VF(1); SBAR(); if (NT > 2) SLOAD_F((const float*)Kh, KBASE(2)); } else SWRITE_H(1); }
    __syncthreads();
#define HALF_STEP(PX0, PX1, mnX, alX, PY0, PY1, alY, t, KB, VB, SB) do {                                                      \
        SBAR(); qkt<KB, SK>(PX0, PX1, K_lds, r32, hi, S.qr, ACT(t));                                             \
        finishSM(PY0, PY1, alY, l_reg, pa0, pa1, pa2, pa3); SBAR();                                                           \
        if ((t) + 1 < NT) { if constexpr (F32) { VMW(); SWRITE_KF(SB); SBAR(); SLOAD_F((const float*)Vh, KBASE((t) + 1)); }  \
                            else { SLOAD_H(Kh, Vh, KBASE((t) + 1)); } SBAR(); }                                               \
        pv_tile<VB, SK>(o, vb0, pa0, pa1, pa2, pa3, ACT((t) - 1)); MASKT(PX0, PX1, (t)); partialSM(PX0, PX1, m_reg, mnX, alX, CINIT(t));                                        \
        __syncthreads();                                                                                                      \
        if ((t) + 1 < NT) { VMW(); if constexpr (F32) { SWRITE_VF(SB); SBAR(); if ((t) + 2 < NT) SLOAD_F((const float*)Kh, KBASE((t) + 2)); } \
                            else { SWRITE_H(SB); } }                                                                          \
        RESC(alX); __syncthreads(); } while (0)
    for (int t = 1; t + 1 < NT; t += 2) {
        HALF_STEP(pB0, pB1, mnB, alB, pA0, pA1, alA, t, 1, 0, 0);
        HALF_STEP(pA0, pA1, mnA, alA, pB0, pB1, alB, t + 1, 0, 1, 1);
    }
    const bool even = (NT & 1) == 0;
    if (even) { SBAR(); qkt<1, SK>(pB0, pB1, K_lds, r32, hi, S.qr, ACT(NT - 1)); SBAR(); }
#define QROW(e) (nxt.Q + (size_t)(wid * QBLK + r32) * LDQ + ((e) >> 1) * 16 + hi * 8 + ((e) & 1) * 4)
    if constexpr (F32) { SLOAD_F((const float*)nxt.K, kbn); SBAR();
#pragma unroll
        for (int e = 0; e < 8; ++e) S.tq[e] = *(const f32x4*)QROW(e); }
    else { SLOAD_H(nxt.K, nxt.V, kbn); SBAR();
#pragma unroll
        for (int d0 = 0; d0 < 8; ++d0) S.qr[d0] = load8<TIn>(nxt.Q + (unsigned)((wid * QBLK + r32) * LDQ + d0 * 16 + hi * 8)); }
    SBAR();
    finishSM(pA0, pA1, alA, l_reg, pa0, pa1, pa2, pa3); SBAR();
    if constexpr (F32) {
#pragma unroll
        for (int e = 8; e < 16; ++e) S.tq[e] = *(const f32x4*)QROW(e); SBAR(); }
#undef QROW
    pv_tile<0, SK>(o, vb0, pa0, pa1, pa2, pa3, ACT(even ? NT - 2 : NT - 1));
    if (even) { MASKT(pB0, pB1, NT - 1); partialSM(pB0, pB1, m_reg, mnB, alB, CINIT(NT - 1)); __syncthreads(); RESC(alB);
        finishSM(pB0, pB1, alB, l_reg, pa0, pa1, pa2, pa3); SBAR(); pv_tile<1, SK>(o, vb0, pa0, pa1, pa2, pa3, ACT(NT - 1)); }
    SBAR(); SEAM_K0();
    if (hi == 0) li_l[r32] = l_reg; asm volatile("s_waitcnt lgkmcnt(0)" ::: "memory");
    float rli[16];
#pragma unroll
    for (int r = 0; r < 16; ++r) rli[r] = __builtin_amdgcn_rcpf(li_l[crow(r, hi)]);
    TOut* Ow = cur.O;
#pragma unroll
    for (int r = 0; r < 16; ++r) { const int orow = crow(r, hi);
#pragma unroll
        for (int d0 = 0; d0 < 4; ++d0) { const float v = o[d0][r] * rli[r];
            if constexpr (same_t<TOut, float>::v) { Ow[(unsigned)((wid * QBLK + orow) * LDQ + d0 * 32 + r32)] = v; }
            else { const float vn = __shfl_xor(v, 1);
                   if ((r32 & 1) == 0) *(unsigned*)(Ow + (unsigned)((wid * QBLK + orow) * LDQ + d0 * 32 + r32)) = cvtpk(v, vn); } } }
    if constexpr (F32) {
#pragma unroll
        for (int d0 = 0; d0 < 8; ++d0) S.qr[d0] = pack8(S.tq[2 * d0], S.tq[2 * d0 + 1]); }
    __syncthreads();
#undef RESC
#undef KBASE
#undef ACT
#undef MASKT
#undef CINIT
#undef SEAM_K0
#undef HALF_STEP
}
#undef ROW
#undef VMW
#undef VMWN
#undef SLOAD_H
#undef SWRITE_HK
#undef SWRITE_HV
#undef SWRITE_H
#undef SLOAD_F
#undef SWRITE_KF
#undef SWRITE_VF
}
namespace mk {
typedef att::BlockRef<att::bf16, att::bf16> ARef;

__device__ __forceinline__ ARef moba_ref(PPtr p, int L, int pass, att::bf16* oalt = nullptr) {
    const int xcd = L & 7, kk = L >> 3, bh = xcd + 8 * (kk >> 3), pr = kk & 7, b = bh >> 3, h = bh & 7;
    const int qb = pass ? 15 - pr : pr;
    ARef r;
    att::bf16* Q = (att::bf16*)(p->ws + WS_Q); const att::bf16* K = (const att::bf16*)(p->ws + WS_K); const att::bf16* V = (const att::bf16*)(p->ws + WS_V);
    r.Q = Q + ((size_t)b * S + (size_t)qb * 256) * 1024 + h * 128; r.O = Q + ((size_t)b * S + (size_t)qb * 256) * 1024 + h * 128;
    r.K = K + (size_t)b * S * 1024 + h * 128; r.V = V + (size_t)b * S * 1024 + h * 128; r.P0 = qb * 256;
    if (oalt) r.O = oalt + ((size_t)b * S + (size_t)qb * 256) * 1024 + h * 128;
    r.kp = (const float*)(p->ws + WS_KPART) + (size_t)b * 16 * 2 * 1024; r.btg = (const float*)(p->ws + WS_BTAB) + h * 128; r.h = h;
    return r;
}
template <int MODE = 1> __device__ __forceinline__ void phase_moba(PPtr p, char* lds, int G, const int tid, att::bf16* oalt = nullptr) {
    constexpr int total = 512;
    int L = blockIdx.x; if (L >= total) return;
    int pass = 0;
    ARef cur = moba_ref(p, L, 0, oalt);
    att::Seam<att::bf16> Sm;
    att::causal_swa_prime<att::bf16, att::bf16, MODE, 1024, 1024>(cur, 1 << 30, lds, Sm, tid);
    for (;;) {
        const bool more_pass = pass == 0, more_item = L + G < total, last = !more_pass && !more_item;
        int passn = pass + 1, Ln = L;
        if (!more_pass) { passn = 0; Ln = more_item ? L + G : L; }
        const ARef nxt = last ? cur : moba_ref(p, Ln, passn, oalt);
        att::causal_swa_block<att::bf16, att::bf16, MODE, 1024, 1024>(cur, nxt, S, 1 << 30, lds, Sm, tid);
        if (last) break;
        cur = nxt; pass = passn; L = Ln;
    }
}
__device__ __forceinline__ bool xattn_ref(PPtr p, int k, int G, ARef& r, att::bf16* oalt) {
    const int L = (k >> 1) * G + (int)blockIdx.x; if (L >= 128 * 2) return false;
    int pm, pn; tile_order(L, 128, 2, pm, pn);
    const int b = pm >> 4, qb = pm & 15, xh = 2 * pn + (k & 1);
    att::bf16* Q = (att::bf16*)(p->ws + WS_Q2); const att::bf16* KV = (const att::bf16*)(p->ws + WS_KVM);
    r.Q = Q + ((size_t)b * S + (size_t)qb * 256) * XW + xh * 128; r.O = Q + ((size_t)b * S + (size_t)qb * 256) * XW + xh * 128;
    r.K = KV + (size_t)b * MEM * 1024 + xh * 128; r.V = KV + (size_t)b * MEM * 1024 + 512 + xh * 128; r.P0 = 256;
    if (oalt) r.O = oalt + ((size_t)b * S + (size_t)qb * 256) * XW + xh * 128;
    r.kp = nullptr; r.btg = nullptr; r.h = 0;
    return true;
}
__device__ __forceinline__ void phase_xattn(PPtr p, char* lds, int G, const int tid, att::bf16* oalt) {
    ARef cur, nxt;
    if (!xattn_ref(p, 0, G, cur, oalt)) return;
    att::Seam<att::bf16> Sm;
    att::causal_swa_prime<att::bf16, att::bf16, 0, 512, 1024>(cur, 1 << 30, lds, Sm, tid);
    for (int k = 0;; ++k) {
        const bool last = !xattn_ref(p, k + 1, G, nxt, oalt);
        if (last) nxt = cur;
        att::causal_swa_block<att::bf16, att::bf16, 0, 512, 1024>(cur, nxt, MEM, 1 << 30, lds, Sm, tid);
        if (last) break;
        cur = nxt;
    }
}

template <int VAR = 0> __device__ __forceinline__ void phase_sgu(PPtr p, LAS unsigned char* lds, int G, const int tid) {
    typedef short s16x4 __attribute__((ext_vector_type(4)));
    const int lane = tid & 63, wave = __builtin_amdgcn_readfirstlane(tid >> 6);
    bf16* U = (bf16*)(p->ws + WS_U); const bf16* GV = (const bf16*)(p->ws + WS_GV); const float* vstat = (const float*)(p->ws + WS_VSTAT);
    const bf16* WSP = (const bf16*)(p->ws + WS_WSP);
    constexpr int RS = 40;
    constexpr int NUNITS = (T / 128) * 8;
    LAS unsigned char* img = lds + wave * 5120;
    LAS float* rtab = (LAS float*)(lds + 8 * 5120);
    const int fr = lane & 15, kg = lane >> 4;
    const int bx = blockIdx.x;
    { const int nun = (NUNITS - bx + G - 1) / G;
_Pragma("unroll 2")
      for (int e = tid; e < nun * 128; e += NTHREADS) { const int j = e >> 7, unit = bx + j * G; rtab[e] = row_rstd(vstat, (size_t)((unit >> 3) * 128 + (e & 127))); } }
    __syncthreads();
    bf16x8 wf[20]; int g_have = -1;
    v2u uuA[8], uuB[8]; v4u gvA[4], gvB[4];
#define SGU_LOAD(unit_, uu_, gv_) do { const int g_ = (unit_) & 7, t0_ = ((unit_) >> 3) * 128; \
        _Pragma("unroll") for (int i = 0; i < 8; ++i) { if (VAR == 3) uu_[i] = (v2u){(unsigned)t0_, (unsigned)i}; else if (VAR == 5) uu_[i] = *(const v2u*)(U + ((size_t)(unit_) * 8 + wave) * 2048 + (size_t)(i * 64 + lane) * 4); else uu_[i] = *(const v2u*)(U + (size_t)(t0_ + 16 * i + fr) * 1024 + g_ * 128 + 16 * wave + 4 * kg); } \
        _Pragma("unroll") for (int i = 0; i < 4; ++i) { if (VAR == 2) gv_[i] = (v4u){(unsigned)t0_, (unsigned)i, 1u, 2u}; else if (VAR == 5) gv_[i] = *(const v4u*)(GV + ((size_t)(unit_) * 8 + wave) * 2048 + (size_t)(i * 64 + lane) * 8); else gv_[i] = *(const v4u*)(GV + (size_t)(t0_ + (lane >> 1) + 32 * i) * 1024 + g_ * 128 + 16 * wave + (lane & 1) * 8); } } while (0)
#define SGU_UNIT(unit_, j_, uu_, gv_) do { const int g = (unit_) & 7, t0 = ((unit_) >> 3) * 128; \
        if (g != g_have) { const bf16* wg = WSP + (size_t)g * 128 * 128; int n_ = 0;     \
            _Pragma("unroll") for (int i = 0; i < 8; ++i) _Pragma("unroll") for (int ks = 0; ks < 4; ++ks) if (ks < (16 * i + 15) / 32 + 1) { wf[n_] = *(const bf16x8*)(wg + (size_t)(16 * i + fr) * 128 + 32 * ks + 8 * kg); ++n_; } \
            g_have = g; } \
        float bbv[8]; _Pragma("unroll") for (int i = 0; i < 8; ++i) bbv[i] = p->b_spatial[g * 128 + 16 * i + fr];     \
        const f32x4 n0 = *(const f32x4*)(p->sgu_norm + g * 128 + 16 * wave + (lane & 1) * 8), n1 = *(const f32x4*)(p->sgu_norm + g * 128 + 16 * wave + (lane & 1) * 8 + 4); \
        if (VAR != 4 && VAR != 5) { _Pragma("unroll") for (int i = 0; i < 4; ++i) { const int s_ = (lane >> 1) + 32 * i; const float rs = rtab[(j_) * 128 + s_]; const v4u w = gv_[i]; \
            v4u o; o.x = pk2(bflo(w.x) * rs * n0[0], bfhi(w.x) * rs * n0[1]); o.y = pk2(bflo(w.y) * rs * n0[2], bfhi(w.y) * rs * n0[3]); \
            o.z = pk2(bflo(w.z) * rs * n1[0], bfhi(w.z) * rs * n1[1]); o.w = pk2(bflo(w.w) * rs * n1[2], bfhi(w.w) * rs * n1[3]); \
            LAS unsigned char* d = img + s_ * RS + (lane & 1) * 16; *(LAS v2u*)d = (v2u){o.x, o.y}; *(LAS v2u*)(d + 8) = (v2u){o.z, o.w}; } } \
        asm volatile("s_waitcnt lgkmcnt(0)" ::: "memory"); \
        bf16x8 af[4];     \
        if (VAR == 4 || VAR == 5) { _Pragma("unroll") for (int ks = 0; ks < 4; ++ks) af[ks] = (bf16x8){(short)gv_[ks].x, 0, 0, 0, 0, 0, 0, 0}; } else \
        { const int q = (lane & 15) >> 2, pp = lane & 3; const LAS unsigned char* base = img + (8 * kg + q) * RS + pp * 8; \
          _Pragma("unroll") for (int ks = 0; ks < 4; ++ks) { s16x4 lo, hi; \
              asm volatile("ds_read_b64_tr_b16 %0, %1" : "=v"(lo) : "v"(base + (32 * ks) * RS) : "memory"); \
              asm volatile("ds_read_b64_tr_b16 %0, %1" : "=v"(hi) : "v"(base + (32 * ks + 4) * RS) : "memory"); \
              asm volatile("s_waitcnt lgkmcnt(0)" : "+v"(lo), "+v"(hi) :: "memory"); \
              af[ks] = (bf16x8){lo[0], lo[1], lo[2], lo[3], hi[0], hi[1], hi[2], hi[3]}; } } \
        __builtin_amdgcn_sched_barrier(0); \
        int n = 0; \
        _Pragma("unroll") for (int i = 0; i < 8; ++i) { f32x4 acc = {0.f, 0.f, 0.f, 0.f}; \
            if (VAR == 4 || VAR == 5) { acc[0] = __builtin_bit_cast(float, (int)af[i & 3][0]); } else { _Pragma("unroll") for (int ks = 0; ks < 4; ++ks) if (ks < (16 * i + 15) / 32 + 1) { acc = __builtin_amdgcn_mfma_f32_16x16x32_bf16(af[ks], wf[n], acc, 0, 0, 0); ++n; } } \
            const float bb = bbv[i];     \
            v2u r; r.x = pk2(gelu_tanh(bflo(uu_[i].x)) * (acc[0] + bb), gelu_tanh(bfhi(uu_[i].x)) * (acc[1] + bb)); r.y = pk2(gelu_tanh(bflo(uu_[i].y)) * (acc[2] + bb), gelu_tanh(bfhi(uu_[i].y)) * (acc[3] + bb));     \
            if (VAR == 5) *(v2u*)(U + ((size_t)(unit_) * 8 + wave) * 2048 + (size_t)(i * 64 + lane) * 4) = r; else if (VAR != 1 || r.x == 0x12345678u) *(v2u*)(U + (size_t)(t0 + 16 * i + fr) * 1024 + g * 128 + 16 * wave + 4 * kg) = r; } } while (0)
    if (bx < NUNITS) {
        SGU_LOAD(bx, uuA, gvA);
        int j = 0;
        for (int unit = bx; unit < NUNITS; unit += 2 * G, j += 2) {
            const bool hb = unit + G < NUNITS;
            if (hb) SGU_LOAD(unit + G, uuB, gvB);
            SGU_UNIT(unit, j, uuA, gvA);
            if (!hb) break;
            const bool ha = unit + 2 * G < NUNITS;
            if (ha) SGU_LOAD(unit + 2 * G, uuA, gvA);
            SGU_UNIT(unit + G, j + 1, uuB, gvB);
            if (!ha) break;
        }
    }
#undef SGU_LOAD
#undef SGU_UNIT
    __syncthreads();
}
}
namespace mk {
__device__ __forceinline__ void build_tiles(PPtr p, LAS unsigned char* lds, const int tid) {
    LAS int* tb = (LAS int*)(lds + LDS_MISC);
    const int* counts = (const int*)(p->ws + WS_CTL);
    if (tid == 0) {
        int tl = 0;
        for (int e = 0; e < NE; ++e) { tb[e] = tl * 256; const int nt = (__hip_atomic_load(counts + e, __ATOMIC_RELAXED, __HIP_MEMORY_SCOPE_AGENT) + 255) >> 8; for (int i = 0; i < nt; ++i) tb[128 + tl + i] = e; tl += nt; }
        tb[64] = tl;
    }
    __syncthreads();
}
template <class FP> __device__ __forceinline__ void route_token(FP rl, const float* __restrict__ b_rg, const float* __restrict__ b_re, int t, int* __restrict__ eid, float* __restrict__ wt, LAS int* hist) {
    float g[8]; float gm = -3.0e38f; int gs = 0;
#pragma unroll
    for (int i = 0; i < 8; ++i) { g[i] = rl[i] + b_rg[i]; if (g[i] > gm) { gm = g[i]; gs = i; } }
    float gsum = 0.f;
#pragma unroll
    for (int i = 0; i < 8; ++i) gsum += __expf(g[i] - gm);
    const float pg = 1.0f / gsum;
    float e[8]; float em = -3.0e38f;
#pragma unroll
    for (int i = 0; i < 8; ++i) { e[i] = rl[8 + gs * 8 + i] + b_re[gs * 8 + i]; em = fmaxf(em, e[i]); }
    float esum = 0.f; float pe[8];
#pragma unroll
    for (int i = 0; i < 8; ++i) { pe[i] = __expf(e[i] - em); esum += pe[i]; }
#pragma unroll
    for (int i = 0; i < 8; ++i) pe[i] /= esum;
    int i0 = 0; float p0 = pe[0];
#pragma unroll
    for (int i = 1; i < 8; ++i) if (pe[i] > p0) { p0 = pe[i]; i0 = i; }
    int i1 = -1; float p1 = -1.0f;
#pragma unroll
    for (int i = 0; i < 8; ++i) if (i != i0 && pe[i] > p1) { p1 = pe[i]; i1 = i; }
    const float ps = p0 + p1;
    const int e0 = gs * 8 + i0, e1 = gs * 8 + i1;
    eid[2 * t] = e0; eid[2 * t + 1] = e1; wt[2 * t] = pg * (p0 / ps); wt[2 * t + 1] = pg * (p1 / ps);
    __hip_atomic_fetch_add(hist + e0, 1, __ATOMIC_RELAXED, __HIP_MEMORY_SCOPE_WORKGROUP); __hip_atomic_fetch_add(hist + e1, 1, __ATOMIC_RELAXED, __HIP_MEMORY_SCOPE_WORKGROUP);
}
__device__ __forceinline__ void init_slots(PPtr p, int vcu, int G, const int tid) {
    const int gt = vcu * NTHREADS + tid, NGT = G * NTHREADS;
    int* slotp = (int*)(p->ws + WS_SLOTP); unsigned* slotoff = (unsigned*)(p->ws + WS_SLOTOFF);
    for (int i = gt; i < MAXSLOTS; i += NGT) { slotp[i] = -1; slotoff[i] = 0u; }
}
struct EpiRouteFused {
    static constexpr bool PERM = true, AFTER_DRAIN = true, CHAIN = false;
    const float* stat; const float* b_rg; const float* b_re; int* eid; float* wt; int* counts;
    __device__ __forceinline__ void fused(f32x4 (&acc)[2][2][4][2], const Unit& u, int wr, int wc, int fr, int fq, LAS unsigned char* lds, int wid, int lane) const {
        LAS float* L = (LAS float*)lds;
        LAS int* hist = (LAS int*)(lds + 256 * 73 * 4);
        const int tid = wid * 64 + lane;
        if (tid < NE) hist[tid] = 0;
        const int row0 = u.pm * 256 + wr * 64 + fr;
        float rsv[8];
#pragma unroll
        for (int k = 0; k < 8; ++k) rsv[k] = row_rstd(stat, (size_t)EPI_ROWS(k >> 2, k & 3));
#pragma unroll
        for (int ai = 0; ai < 2; ++ai)
#pragma unroll
            for (int m = 0; m < 4; ++m) { const int rl = ai * 128 + wr * 64 + m * 16 + fr; const float rs = rsv[ai * 4 + m];
#pragma unroll
                for (int n = 0; n < 2; ++n)
#pragma unroll
                    for (int j = 0; j < 4; ++j) { const int col = 32 * wc + 8 * fq + 4 * n + j; if (col < 72) L[rl * 73 + col] = acc[ai][0][m][n][j] * rs; } }
        __syncthreads();
        if (tid < 256) route_token(L + tid * 73, b_rg, b_re, u.pm * 256 + tid, eid, wt, hist);
        __syncthreads();
        if (tid < NE) { const int c = hist[tid]; if (c) atomicAdd(counts + tid, c); }
    }
};
__device__ __forceinline__ void phase_dispatch(PPtr p, LAS unsigned char* lds, int vcu, int G, const int tid) {
    build_tiles(p, lds, tid);
    const LAS int* tb = (const LAS int*)(lds + LDS_MISC);
    const int gt = vcu * NTHREADS + tid, NGT = G * NTHREADS;
    const int* eid = (const int*)(p->ws + WS_EID); int* cursor = (int*)(p->ws + WS_CTL) + 64;
    int* slotp = (int*)(p->ws + WS_SLOTP); float* slotrs = (float*)(p->ws + WS_SLOTRS); unsigned* slotoff = (unsigned*)(p->ws + WS_SLOTOFF);
    const float* st2 = (const float*)(p->ws + WS_ST2);
    for (int pr = gt; pr < 2 * T; pr += NGT) {
        const int e = eid[pr], tok = pr >> 1;
        const int slot = tb[e] + atomicAdd(cursor + e, 1);
        slotp[slot] = pr; slotoff[slot] = (unsigned)tok * 1024u; slotrs[slot] = row_rstd(st2, (size_t)tok);
    }
}
constexpr int NPRE = 5, TABA_OFF = LDS_MISC + 2048, TABB_OFF = LDS_MISC + 8448;
struct SchedExpert {
    const char* A; const char* B; size_t a_tstep, b_estep, b_tstep; const LAS int* tb; int G, c; const unsigned* slotoff; int nt;
    const LAS unsigned* taba;
    __device__ __forceinline__ bool next(int i, Unit& u) const {
        const int L = i * G + c; if (L >= nt * 4) return false;
        int w = L; { const int nwg = nt * 4, q = nwg / 8, r = nwg % 8, xcd = w % 8, off = w / 8; w = (xcd < r ? xcd * (q + 1) : r * (q + 1) + (xcd - r) * q) + off; }
        const int ti = w >> 2, pn = w & 3, e = __builtin_amdgcn_readfirstlane(tb[128 + ti]);
        u.pm = ti; u.pn = pn; u.A = A + (size_t)ti * a_tstep; u.B = B + (size_t)e * b_estep + (size_t)pn * b_tstep; u.aux = e; u.ord = i; return true; }
    __device__ __forceinline__ const unsigned* rowtab(const Unit& u) const { return slotoff + (size_t)u.pm * 256; }
    __device__ __forceinline__ const LAS unsigned* rowtab_lds(const Unit& u) const { return (taba && u.ord < NPRE) ? taba + u.ord * 256 : nullptr; }
    __device__ __forceinline__ void a_ready(const Unit&) const {}
    __device__ __forceinline__ void done(const Unit&) const {}
};
__device__ __forceinline__ void preload_unit_tables(const SchedExpert& S, LAS unsigned char* lds, const int tid, const unsigned* srcA, const unsigned* srcB) {
    LAS unsigned* ta = (LAS unsigned*)(lds + TABA_OFF); LAS unsigned* tbb = (LAS unsigned*)(lds + TABB_OFF);
#pragma unroll 1
    for (int i = 0; i < NPRE; ++i) { Unit u; if (!S.next(i, u)) break;
        if (tid < 256) { ta[i * 256 + tid] = srcA[(size_t)u.pm * 256 + tid]; if (srcB) tbb[i * 256 + tid] = srcB[(size_t)u.pm * 256 + tid]; } }
    __syncthreads();
}
struct EpiG7 {
    static constexpr bool PERM = true, AFTER_DRAIN = false, CHAIN = false;
    unsigned char* HDN; const float* slotrs; const LAS float* tabb;
    __device__ __forceinline__ void operator()(AccRef acc, const Unit& u, int wr, int wc, int fr, int fq) const {
        const int row0 = u.pm * 256 + wr * 64 + fr, c0 = u.pn * 128 + wc * 32 + 8 * fq;
        float lim = 448.f; asm volatile("" : "+s"(lim));
        float rsv[8];
#pragma unroll
        for (int k = 0; k < 8; ++k) rsv[k] = (u.ord < NPRE ? tabb[u.ord * 256 + wr * 64 + fr + (k >> 2) * 128 + (k & 3) * 16] : slotrs[EPI_ROWS(k >> 2, k & 3)]) * (1.0f / WGU_SCALE);
#pragma unroll
        for (int ai = 0; ai < 2; ++ai)
#pragma unroll
            for (int m = 0; m < 4; ++m) { const size_t r = (size_t)EPI_ROWS(ai, m); const float rs = rsv[ai * 4 + m];
                f32x4 a = acc[ai][0][m][0] * rs, b = acc[ai][0][m][1] * rs; const f32x4 ua = acc[ai][1][m][0] * (rs * HDN_SCALE), ub = acc[ai][1][m][1] * (rs * HDN_SCALE);
#pragma unroll
                for (int j = 0; j < 4; ++j) { a[j] = fminf(fmaxf(a[j] * sigmoid_f(a[j]) * ua[j], -lim), lim); b[j] = fminf(fmaxf(b[j] * sigmoid_f(b[j]) * ub[j], -lim), lim); }
                v2u w8; w8.x = pk4_fp8(a[0], a[1], a[2], a[3]); w8.y = pk4_fp8(b[0], b[1], b[2], b[3]);
                *(v2u*)(HDN + r * EH + c0) = w8; }
    }
};
struct EpiG8 {
    static constexpr bool PERM = true, AFTER_DRAIN = false, CHAIN = false;
    unsigned char* Y; const int* slotp; const LAS int* taba;
    __device__ __forceinline__ void operator()(AccRef acc, const Unit& u, int wr, int wc, int fr, int fq) const {
        const int row0 = u.pm * 256 + wr * 64 + fr, c0 = u.pn * 256 + wc * 32 + 8 * fq;
        constexpr float sc = Y_SCALE / (HDN_SCALE * WD_SCALE);
        int prv[8];
#pragma unroll
        for (int k = 0; k < 8; ++k) prv[k] = u.ord < NPRE ? taba[u.ord * 256 + wr * 64 + fr + (k >> 2) * 128 + (k & 3) * 16] : slotp[EPI_ROWS(k >> 2, k & 3)];
#pragma unroll
        for (int ai = 0; ai < 2; ++ai)
#pragma unroll
            for (int m = 0; m < 4; ++m) { const int pr = prv[ai * 4 + m];
                if (pr >= 0) {
#pragma unroll
                    for (int bj = 0; bj < 2; ++bj) { const f32x4 a = acc[ai][bj][m][0] * sc, b = acc[ai][bj][m][1] * sc; v2u w8; w8.x = pk4_fp8(a[0], a[1], a[2], a[3]); w8.y = pk4_fp8(b[0], b[1], b[2], b[3]);
                        *(v2u*)(Y + ((unsigned)pr * 1024u + (unsigned)(c0 + bj * 128))) = w8; } } }
    }
};
__device__ __forceinline__ void phase_final(PPtr p, int vcu, int G, const int tid, float* oalt) {
    const int lane = tid & 63, wave = tid >> 6; const int gw = vcu * NWAVES + wave, NGW = G * NWAVES;
    const unsigned char* Y = p->ws + WS_Y; const float* wt = (const float*)(p->ws + WS_WT); const bf16* HB = (const bf16*)(p->ws + WS_HB);
    float* outp = oalt ? oalt : p->out;
    f32x4 gg[2][2];
#pragma unroll
    for (int j = 0; j < 2; ++j) { gg[j][0] = *(const f32x4*)(p->norm_final + (lane + 64 * j) * 8); gg[j][1] = *(const f32x4*)(p->norm_final + (lane + 64 * j) * 8 + 4); }
    for (int t = gw; t < T; t += NGW) {
        const float w0 = wt[2 * t] * (1.0f / Y_SCALE), w1 = wt[2 * t + 1] * (1.0f / Y_SCALE);
        const v4u* hr = (const v4u*)(HB + (size_t)t * 1024) + lane;
        const v2u* y0 = (const v2u*)(Y + (size_t)(2 * t) * 1024) + lane; const v2u* y1 = (const v2u*)(Y + (size_t)(2 * t + 1) * 1024) + lane;
        v4u hv[2]; v2u av[2], bv[2];
#pragma unroll
        for (int j = 0; j < 2; ++j) { hv[j] = hr[64 * j]; av[j] = y0[64 * j]; bv[j] = y1[64 * j]; }
        f32x4 v[2][2]; float s = 0.f;
#pragma unroll
        for (int j = 0; j < 2; ++j) { const v4u h = hv[j]; const f32x4 a0 = unpk4_fp8(av[j].x), a1 = unpk4_fp8(av[j].y), b0 = unpk4_fp8(bv[j].x), b1 = unpk4_fp8(bv[j].y);
            v[j][0] = (f32x4){bflo(h.x) + (w0 * a0[0] + w1 * b0[0]), bfhi(h.x) + (w0 * a0[1] + w1 * b0[1]), bflo(h.y) + (w0 * a0[2] + w1 * b0[2]), bfhi(h.y) + (w0 * a0[3] + w1 * b0[3])};
            v[j][1] = (f32x4){bflo(h.z) + (w0 * a1[0] + w1 * b1[0]), bfhi(h.z) + (w0 * a1[1] + w1 * b1[1]), bflo(h.w) + (w0 * a1[2] + w1 * b1[2]), bfhi(h.w) + (w0 * a1[3] + w1 * b1[3])};
#pragma unroll
            for (int q = 0; q < 2; ++q) s += (v[j][q][0] * v[j][q][0] + v[j][q][1] * v[j][q][1]) + (v[j][q][2] * v[j][q][2] + v[j][q][3] * v[j][q][3]); }
        const float rstd = rsqrtf(wave_sum(s) * (1.f / 1024.f) + EPS);
        f32x4* orow = (f32x4*)(outp + (size_t)t * 1024);
#pragma unroll
        for (int j = 0; j < 2; ++j) { __builtin_nontemporal_store(v[j][0] * rstd * gg[j][0], orow + (lane + 64 * j) * 2); __builtin_nontemporal_store(v[j][1] * rstd * gg[j][1], orow + (lane + 64 * j) * 2 + 1); }
    }
}
}
#define XB_TMO      128
#define XB_XCNT(j)  (256  + 64 * (j))
#define XB_XSUB(j)  (1280 + 64 * (j))
#define XB_XGEN(j)  (2304 + 64 * (j))
#define XB_TOP      3328
#define XB_TOPGEN   3392
#define XCD_BAR_WORDS 3456
#define XB_SPIN_CAP (1u << 23)

__device__ __forceinline__ unsigned xb_ld(unsigned* p)              { return __hip_atomic_load(p, __ATOMIC_RELAXED, __HIP_MEMORY_SCOPE_AGENT); }
__device__ __forceinline__ unsigned xb_add(unsigned* p, unsigned v) { return __hip_atomic_fetch_add(p, v, __ATOMIC_RELAXED, __HIP_MEMORY_SCOPE_AGENT); }
__device__ __forceinline__ unsigned xb_xcc_id() { return (unsigned)__builtin_amdgcn_s_getreg((3 << 11) | 20) & 0xFu; }
#define XB_SPIN(cond, bar) do { unsigned _sp = 0; while (cond) { __builtin_amdgcn_s_sleep(1); \
    if ((++_sp & 255u) == 0u) { if (xb_ld(&(bar)[XB_TMO])) break; if (_sp > XB_SPIN_CAP) { atomicAdd(&(bar)[XB_TMO], 1u); break; } } } } while (0)

struct XcdBarrier {
    unsigned* bar; unsigned x;
    volatile LAS unsigned* st;
};

__device__ __forceinline__ XcdBarrier xcd_barrier_post(unsigned* bar, volatile LAS unsigned* st, const int tid) {
    XcdBarrier b; b.bar = bar; b.x = xb_xcc_id(); b.st = st;
    if (tid == 0) (void)xb_add(&bar[XB_XCNT(b.x)], 1u);
    return b;
}
__device__ __forceinline__ void xcd_barrier_complete(unsigned* bar, unsigned x, unsigned& nloc, unsigned& nx) {
    const unsigned G = gridDim.x * gridDim.y * gridDim.z;
    unsigned sum, cnt, mine, sp = 0u;
    for (;;) {
        sum = 0u; cnt = 0u; mine = 0u;
#pragma unroll
        for (unsigned j = 0; j < 16; ++j) { const unsigned c = xb_ld(&bar[XB_XCNT(j)]); sum += c; cnt += (c > 0u) ? 1u : 0u; mine = (j == x) ? c : mine; }
        if (sum == G) break;
        __builtin_amdgcn_s_sleep(1);
        if ((++sp & 255u) == 0u) { if (xb_ld(&bar[XB_TMO])) break; if (sp > XB_SPIN_CAP) { atomicAdd(&bar[XB_TMO], 1u); break; } }
    }
    nloc = mine > 0u ? mine : 1u; nx = cnt > 0u ? cnt : 1u;
}

__device__ __forceinline__ void xcd_barrier(const XcdBarrier& b, const int tid) {
    asm volatile("s_waitcnt vmcnt(0)" ::: "memory");
    __syncthreads();
    if (tid == 0) {
        unsigned* bar = b.bar;
        __builtin_amdgcn_s_waitcnt(0);
        unsigned nloc = b.st[0], nx = b.st[1];
        if (nloc == 0u) { xcd_barrier_complete(bar, b.x, nloc, nx); b.st[0] = nloc; b.st[1] = nx; }
        const unsigned old = xb_add(&bar[XB_XSUB(b.x)], 1u);
        const unsigned gen = old / nloc;
        if (old + 1u == (gen + 1u) * nloc) {
            __builtin_amdgcn_fence(__ATOMIC_RELEASE, "agent");
            asm volatile("s_waitcnt vmcnt(0)" ::: "memory");
            const unsigned og = xb_add(&bar[XB_TOP], 1u);
            const unsigned tg = og / nx;
            if (og + 1u == (tg + 1u) * nx) xb_add(&bar[XB_TOPGEN], 1u);
            else XB_SPIN(xb_ld(&bar[XB_TOPGEN]) == tg, bar);
            __builtin_amdgcn_fence(__ATOMIC_ACQUIRE, "agent");
            xb_add(&bar[XB_XGEN(b.x)], 1u);
            asm volatile("s_waitcnt vmcnt(0)" ::: "memory");
        } else {
            XB_SPIN(xb_ld(&bar[XB_XGEN(b.x)]) == gen, bar);
            __builtin_amdgcn_fence(__ATOMIC_ACQUIRE, "agent");
            asm volatile("s_waitcnt vmcnt(0)" ::: "memory");
        }
    }
    __syncthreads();
}
namespace mk {
constexpr int N_PHASES = 14;
#ifndef MK_N_LAUNCHES
#define MK_N_LAUNCHES 1
#endif
#ifndef MK_BAR_EXTRA
#define MK_BAR_EXTRA
#endif
#ifndef MK_CG_SYNC0
#define MK_CG_SYNC0 0
#endif

__device__ __forceinline__ int lane_now() { int l; asm volatile("v_mbcnt_lo_u32_b32 %0, -1, 0\n\tv_mbcnt_hi_u32_b32 %0, -1, %0" : "=v"(l)); return l; }

template <int LO, int HI>
__global__ void __launch_bounds__(NTHREADS, 2) mega_fwd(Params pv) {
    extern __shared__ __attribute__((aligned(16))) unsigned char lds_raw[];
    LAS unsigned char* lds = (LAS unsigned char*)lds_raw;
    const int G = gridDim.x, bx = blockIdx.x;
    const int vcu = (G % 8 == 0) ? (bx % 8) * (G / 8) + bx / 8 : bx;
    const int wv = __builtin_amdgcn_readfirstlane((int)threadIdx.x >> 6);
    const PPtr kp = (PPtr)__builtin_amdgcn_kernarg_segment_ptr();
    constexpr int lo = LO, hi = HI;
    constexpr bool multi = (HI - LO) > 1;
#define IN(k) (lo <= (k) && (k) < hi)
#define TIDNOW() (wv * 64 + lane_now())
#define PNOW() ({ PPtr q_ = kp; asm volatile("" : "+s"(q_)); q_; })
    XcdBarrier bar; bar.bar = nullptr; bar.x = 0; bar.st = nullptr;
    if constexpr (multi) {
        const int tid = TIDNOW();
        volatile LAS unsigned* st = (volatile LAS unsigned*)(lds + LDS_MISC + 8192);
        if (tid < 4) st[tid] = 0u;
        __syncthreads();
        bar = xcd_barrier_post((unsigned*)(PNOW()->ws + WS_BAR), st, tid);
    }
#define SEAM(k) do { if constexpr (IN(k) && IN((k) + 1)) { if constexpr (MK_CG_SYNC0 && (k) == LO) { cg::this_grid().sync(); } else { xcd_barrier(bar, TIDNOW()); MK_BAR_EXTRA } } } while (0)
    constexpr size_t TS1024 = (size_t)256 * 1024 * 2, TS512 = (size_t)256 * 512 * 2;

    if constexpr (IN(0)) { phase_prologue(PNOW(), lds, vcu, G, TIDNOW()); } SEAM(0);

    if constexpr (IN(1)) {
        const PPtr p = PNOW(); unsigned char* ws = p->ws;
        SchedG1 S{(const char*)p->out + OUT_XN, (const char*)ws + W_CAT, (const char*)p->out + OUT_MEMN, (const char*)ws + W_XKV, G, bx};
        EpiG1 E{ws, p->b_gate};
        pg8::gemm_phase<EpiG1, SchedG1, true, true>(lds, TIDNOW(), 1024, S, E);
        { constexpr int NU = 128 * 28 + 32; const int nmax = (NU + G - 1) / G, wfull = NU - (nmax - 1) * G;
          phase_convert_experts(PNOW(), lds, vcu, G, 3, TIDNOW(), wfull >= G ? 0 : wfull); }
    } SEAM(1);

    if constexpr (IN(2)) {
        phase_sgu<0>(PNOW(), lds, G, TIDNOW());
        phase_moba<1>(PNOW(), (char*)lds_raw, G, TIDNOW());
    } SEAM(2);

    if constexpr (IN(3)) {
        const PPtr p = PNOW(); unsigned char* ws = p->ws;
        SchedG2 S{(const char*)ws + WS_U, (const char*)ws + W_A, (const char*)ws + WS_Q, (const char*)ws + W_B, G, bx};
        EpiG2 E{ws + WS_G, (bf16*)(ws + WS_MERGED)};
        pg8::gemm_phase<EpiG2, SchedG2, true, true>(lds, TIDNOW(), 1024, S, E);
    } SEAM(3);

    if constexpr (IN(4)) {
        const PPtr p = PNOW(); unsigned char* ws = p->ws;
        SchedPlain S{(const char*)ws + WS_MERGED, (const char*)ws + W_O, 128, 4, G, bx, TS1024};
        EpiRes<true> E{p->x, (bf16*)(ws + WS_HB), (float*)(ws + WS_ST1), (bf16*)(ws + WS_HB), nullptr};
        pg8::gemm_phase<EpiRes<true>, SchedPlain, true, true>(lds, TIDNOW(), 1024, S, E);
    } SEAM(4);

    if constexpr (IN(5)) {
        const PPtr p = PNOW(); unsigned char* ws = p->ws;
        SchedPlain S{(const char*)ws + WS_HB, (const char*)ws + W_XQ, 128, 2, G, bx, TS1024};
        EpiScaleBf16 E{(bf16*)(ws + WS_Q2), XW, (const float*)(ws + WS_ST1)};
        pg8::gemm_phase<EpiScaleBf16, SchedPlain, true, true>(lds, TIDNOW(), 1024, S, E);
        asm volatile("s_waitcnt vmcnt(0)" ::: "memory"); __syncthreads();
        phase_xattn(PNOW(), (char*)lds_raw, G, TIDNOW(), nullptr);
    }
      SEAM(6);

    if constexpr (IN(7)) {
        const PPtr p = PNOW(); unsigned char* ws = p->ws;
        SchedPlain S{(const char*)ws + WS_Q2, (const char*)ws + W_XO, 128, 4, G, bx, TS512};
        EpiRes<false, true> E{nullptr, (bf16*)(ws + WS_HB), (float*)(ws + WS_ST2), (bf16*)(ws + WS_HB), ws + WS_XG8};
        pg8::gemm_phase<EpiRes<false, true>, SchedPlain, true, true>(lds, TIDNOW(), 512, S, E);
    } SEAM(7);

    if constexpr (IN(8)) {
        const PPtr p = PNOW(); unsigned char* ws = p->ws;
        init_slots(p, vcu, G, TIDNOW());
        SchedPlain S{(const char*)ws + WS_HB, (const char*)ws + W_R, 128, 1, G, bx, TS1024};
        EpiRouteFused E{(const float*)(ws + WS_ST2), p->b_rg, p->b_re, (int*)(ws + WS_EID), (float*)(ws + WS_WT), (int*)(ws + WS_CTL)};
        pg8::gemm_phase<EpiRouteFused, SchedPlain, false, true>(lds, TIDNOW(), 1024, S, E);
        __syncthreads();
        if (G > 128) phase_convert_experts(p, lds, vcu, G, 2, TIDNOW(), 128);
    } SEAM(8);

    if constexpr (IN(9)) {
        phase_dispatch(PNOW(), lds, vcu, G, TIDNOW());
        __syncthreads();
        phase_convert_experts(PNOW(), lds, vcu, G, 0, TIDNOW()); phase_convert_experts(PNOW(), lds, vcu, G, 1, TIDNOW()); if (G <= 128) phase_convert_experts(PNOW(), lds, vcu, G, 2, TIDNOW(), 0);
    }
      SEAM(10);

    if constexpr (IN(11)) {
        const PPtr p = PNOW(); unsigned char* ws = p->ws; const int tid = TIDNOW();
        build_tiles(p, lds, tid);
        SchedExpert S{(const char*)ws + WS_XG8, (const char*)ws + WS_WGU, 0, (size_t)1024 * 1024, (size_t)256 * 1024, (const LAS int*)(lds + LDS_MISC), G, bx, (const unsigned*)(ws + WS_SLOTOFF), __builtin_amdgcn_readfirstlane(((const LAS int*)(lds + LDS_MISC))[64]), (const LAS unsigned*)(lds + TABA_OFF)};
        preload_unit_tables(S, lds, tid, (const unsigned*)(ws + WS_SLOTOFF), (const unsigned*)(ws + WS_SLOTRS));
        EpiG7 E{(unsigned char*)p->out + OUT_HDN, (const float*)(ws + WS_SLOTRS), (const LAS float*)(lds + TABB_OFF)};
        pg8::gemm_phase<EpiG7, SchedExpert, true, true, true, true>(lds, tid, 512, S, E);
    } SEAM(11);

    if constexpr (IN(12)) {
        const PPtr p = PNOW(); unsigned char* ws = p->ws; const int tid = TIDNOW();
        build_tiles(p, lds, tid);
        SchedExpert S{(const char*)p->out + OUT_HDN, (const char*)p->out + OUT_WD, (size_t)256 * 512, (size_t)1024 * 512, (size_t)256 * 512, (const LAS int*)(lds + LDS_MISC), G, bx, nullptr, __builtin_amdgcn_readfirstlane(((const LAS int*)(lds + LDS_MISC))[64]), nullptr};
        preload_unit_tables(S, lds, tid, (const unsigned*)(ws + WS_SLOTP), nullptr);
        EpiG8 E{ws + WS_Y, (const int*)(ws + WS_SLOTP), (const LAS int*)(lds + TABA_OFF)};
        pg8::gemm_phase<EpiG8, SchedExpert, true, true, false, true>(lds, tid, 256, S, E);
    } SEAM(12);

    if constexpr (IN(13)) { phase_final(PNOW(), vcu, G, TIDNOW(), nullptr); }
    if constexpr (LO == 14) { phase_convert_experts(PNOW(), lds, vcu, G, 0, TIDNOW()); }
    if constexpr (LO == 15) { phase_convert_experts(PNOW(), lds, vcu, G, 1, TIDNOW()); }
    if constexpr (LO == 18) {
        const PPtr p = PNOW(); unsigned char* ws = p->ws;
        SchedPlain S{(const char*)ws + WS_Q2, (const char*)ws + W_XO, 128, 4, G, bx, TS512};
        EpiRes<false> E{nullptr, (bf16*)(ws + WS_HB), (float*)(ws + WS_VSTAT), (bf16*)(ws + WS_Q), nullptr};
        pg8::gemm_phase<EpiRes<false>, SchedPlain, true, true>(lds, TIDNOW(), 512, S, E);
    }
    if constexpr (LO == 19) { phase_xattn(PNOW(), (char*)lds_raw, G, TIDNOW(), (att::bf16*)(PNOW()->ws + WS_Q)); }
    if constexpr (LO == 20) { phase_final(PNOW(), vcu, G, TIDNOW(), (float*)(PNOW()->ws + WS_G)); }
    if constexpr (LO == 21) {
        const PPtr p = PNOW(); unsigned char* ws = p->ws;
        SchedG1 S{(const char*)p->out + OUT_XN, (const char*)ws + W_CAT, (const char*)p->out + OUT_MEMN, (const char*)ws + W_XKV, G, bx};
        EpiG1T<1> E{ws, p->b_gate};
        pg8::gemm_phase<EpiG1T<1>, SchedG1, true, true>(lds, TIDNOW(), 1024, S, E);
    }
    if constexpr (LO == 28) {
        const PPtr p = PNOW(); unsigned char* ws = p->ws;
        SchedG1 S{(const char*)p->out + OUT_XN, (const char*)ws + W_CAT, (const char*)p->out + OUT_MEMN, (const char*)ws + W_XKV, G, bx};
        EpiG1T<2> E{ws, p->b_gate};
        pg8::gemm_phase<EpiG1T<2>, SchedG1, true, true>(lds, TIDNOW(), 1024, S, E);
    }
    if constexpr (LO == 16) { phase_sgu<0>(PNOW(), lds, G, TIDNOW()); }
    if constexpr (LO == 23) { phase_sgu<1>(PNOW(), lds, G, TIDNOW()); }
    if constexpr (LO == 24) { phase_sgu<2>(PNOW(), lds, G, TIDNOW()); }
    if constexpr (LO == 25) { phase_sgu<3>(PNOW(), lds, G, TIDNOW()); }
    if constexpr (LO == 26) { phase_sgu<4>(PNOW(), lds, G, TIDNOW()); }
    if constexpr (LO == 27) { phase_sgu<5>(PNOW(), lds, G, TIDNOW()); }
    if constexpr (LO == 17) { phase_moba<1>(PNOW(), (char*)lds_raw, G, TIDNOW(), (att::bf16*)PNOW()->out); }
    if constexpr (LO == 22) { phase_moba<2>(PNOW(), (char*)lds_raw, G, TIDNOW(), (att::bf16*)PNOW()->out); }
#undef IN
#undef SEAM
#undef TIDNOW
#undef PNOW
}
}

extern "C" void kernel_launch(void* const* d_in, const int* in_sizes, int n_in, void* d_out, int out_size, void* d_ws, size_t ws_size, hipStream_t stream) {
    static int grid = 0;
    if (grid == 0) {
        if (n_in != 27 || out_size != mk::T * mk::D || ws_size < mk::WS_END) { fprintf(stderr, "kernel_launch: unexpected shapes (n_in %d, out %d, ws %zu)\n", n_in, out_size, ws_size); grid = -1; return; }
        int dev = 0, cus = 0;
        (void)hipGetDevice(&dev); (void)hipDeviceGetAttribute(&cus, hipDeviceAttributeMultiprocessorCount, dev);
        grid = cus;
#if MK_N_LAUNCHES == 1
        int per_cu = 0;
        (void)hipFuncSetAttribute((const void*)mk::mega_fwd<0, mk::N_PHASES>, hipFuncAttributeMaxDynamicSharedMemorySize, mk::LDS_BYTES);
        if (hipOccupancyMaxActiveBlocksPerMultiprocessor(&per_cu, (const void*)mk::mega_fwd<0, mk::N_PHASES>, mk::NTHREADS, mk::LDS_BYTES) != hipSuccess || per_cu < 1) {
            fprintf(stderr, "kernel_launch: occupancy query reports %d workgroups per CU; nothing launched\n", per_cu); grid = -1; return; }
        (void)hipGetLastError();
#endif
    }
    if (grid < 0) return;
    mk::Params p{};
    const float** pp = (const float**)&p;
    for (int i = 0; i < 27; ++i) pp[i] = (const float*)d_in[i];
    p.out = (float*)d_out; p.ws = (unsigned char*)d_ws;
#if MK_N_LAUNCHES == 1
    (void)hipMemsetAsync((unsigned char*)d_ws + mk::WS_BAR, 0, 16384, stream);
    void* args[] = {&p};
    hipError_t e = hipLaunchCooperativeKernel((const void*)mk::mega_fwd<0, mk::N_PHASES>, dim3(grid), dim3(mk::NTHREADS), args, mk::LDS_BYTES, stream);
    if (e != hipSuccess) fprintf(stderr, "cooperative launch failed: %s (grid %d)\n", hipGetErrorString(e), grid);
#else
#define MK_LAUNCH(k) do { static bool ad_ = false; if (!ad_) { ad_ = true; (void)hipFuncSetAttribute((const void*)mk::mega_fwd<k, k + 1>, hipFuncAttributeMaxDynamicSharedMemorySize, mk::LDS_BYTES); } \
        hipLaunchKernelGGL((mk::mega_fwd<k, k + 1>), dim3(grid), dim3(mk::NTHREADS), mk::LDS_BYTES, stream, p); } while (0)
#ifndef MK_X0
#define MK_X0
#endif
#ifndef MK_X1
#define MK_X1
#endif
#ifndef MK_X2
#define MK_X2
#endif
#ifndef MK_X3
#define MK_X3
#endif
#ifndef MK_X4
#define MK_X4
#endif
#ifndef MK_X5
#define MK_X5
#endif
#ifndef MK_X6
#define MK_X6
#endif
#ifndef MK_X7
#define MK_X7
#endif
#ifndef MK_X8
#define MK_X8
#endif
#ifndef MK_X9
#define MK_X9
#endif
#ifndef MK_X10
#define MK_X10
#endif
#ifndef MK_X11
#define MK_X11
#endif
#ifndef MK_X12
#define MK_X12
#endif
#ifndef MK_X13
#define MK_X13
#endif
#ifndef MK_X14
#define MK_X14
#endif
    MK_X0 MK_LAUNCH(0); MK_X1 MK_LAUNCH(1); MK_X2 MK_LAUNCH(2); MK_X3 MK_LAUNCH(3); MK_X4 MK_LAUNCH(4); MK_X5 MK_LAUNCH(5); MK_X6 MK_LAUNCH(6); MK_X7 MK_LAUNCH(7); MK_X8 MK_LAUNCH(8); MK_X9 MK_LAUNCH(9); MK_X10 MK_LAUNCH(10); MK_X11 MK_LAUNCH(11); MK_X12 MK_LAUNCH(12); MK_X13 MK_LAUNCH(13); MK_X14
#undef MK_LAUNCH
#endif
}
```

```cpp
#include <hip/hip_runtime.h>
#include <hip/hip_bf16.h>
#include <hip/hip_cooperative_groups.h>
#include <cstdio>
#include <cstdint>
namespace cg = cooperative_groups;
namespace pg8 {
#define PG8_LAS __attribute__((address_space(3)))
typedef unsigned short bf16_t;
typedef short bf16x8 __attribute__((ext_vector_type(8)));
typedef float f32x4 __attribute__((ext_vector_type(4)));
typedef unsigned u32x4 __attribute__((ext_vector_type(4)));
typedef int v8i32 __attribute__((ext_vector_type(8)));
constexpr int BM = 256, BK = 64, HALF = 128, HTB = HALF * BK * 2  , STAGE_BYTES = 8 * HTB, NXCD = 8, WGM = 8;

__host__ __device__ __forceinline__ int lds_byte(int r, int c) { const int st = (r >> 4) * 2 + (c >> 5), rr = r & 15, cc = c & 31, ob = rr * 64 + cc * 2; return st * 1024 + (ob ^ (((ob >> 9) & 1) << 5)); }
__host__ __device__ __forceinline__ void stage_rc(int b, int& R, int& C) { const int st = b / 1024, sb = b % 1024, swz = sb ^ (((sb >> 9) & 1) << 5); R = (st >> 1) * 16 + swz / 64; C = (st & 1) * 32 + (swz % 64) / 2; }
__host__ __device__ __forceinline__ int perm32(int rho) { const int n = rho >> 4, i = rho & 15; return 8 * (i >> 2) + 4 * n + (i & 3); }

struct Unit { int pm, pn; const char* A; const char* B; int aux; int ord; };
__device__ __forceinline__ unsigned cvt_pk_bf16(float lo, float hi) { unsigned r; asm volatile("v_cvt_pk_bf16_f32 %0, %1, %2" : "=v"(r) : "v"(lo), "v"(hi)); return r; }
template <class Epi, class Sched, bool ALIGN_EPI = false, bool SP2 = false, bool GATHER = false, bool FP8 = false>
__device__ __forceinline__ void gemm_phase(PG8_LAS unsigned char* lds, const int tid, const int K_, const Sched& S, const Epi& E) {
    int K = K_; if constexpr (FP8) asm volatile("" : "+s"(K));
    const int wid = __builtin_amdgcn_readfirstlane(tid >> 6), lane = tid & 63, wr = wid >> 2, wc = wid & 3, fr = lane & 15, fq = lane >> 4;
    const int nt = K / BK;
    unsigned voffA[2], voffB[2];
#pragma unroll
    for (int i = 0; i < 2; ++i) { int R, C; stage_rc(tid * 16 + i * 8192, R, C); const int Rb = Epi::PERM ? ((R & ~31) + perm32(R & 31)) : R;
        voffA[i] = (unsigned)(R * K + C) * 2u; voffB[i] = (unsigned)(Rb * K + C) * 2u; }
    unsigned vA[2][2], vAn[2][2];
    const size_t kstep = (size_t)(BK * 2);
    const size_t hstep = (size_t)HALF * K * 2;
#pragma unroll
    for (int h = 0; h < 2; ++h)
#pragma unroll
        for (int i = 0; i < 2; ++i) { vA[h][i] = voffA[i]; vAn[h][i] = vA[h][i]; }
#define PG8_ROWS(dst, u_) do { const unsigned* rt_ = S.rowtab(u_); int gR[2]; unsigned gC[2]; { int l2_ = lane; if constexpr (FP8) asm volatile("v_mbcnt_lo_u32_b32 %0, -1, 0\n\tv_mbcnt_hi_u32_b32 %0, -1, %0" : "=v"(l2_)); \
        _Pragma("unroll") for (int i = 0; i < 2; ++i) { int R, C; stage_rc((wid * 64 + l2_) * 16 + i * 8192, R, C); gR[i] = R; gC[i] = (unsigned)C * 2u; } }     \
        unsigned x0, x1, x2, x3; const PG8_LAS unsigned* lt_ = S.rowtab_lds(u_); \
        if (lt_) { x0 = lt_[gR[0]]; x1 = lt_[gR[1]]; x2 = lt_[128 + gR[0]]; x3 = lt_[128 + gR[1]]; asm volatile("s_waitcnt lgkmcnt(0)" : "+v"(x0), "+v"(x1), "+v"(x2), "+v"(x3) :: "memory"); }     \
        else { x0 = rt_[gR[0]]; x1 = rt_[gR[1]]; x2 = rt_[128 + gR[0]]; x3 = rt_[128 + gR[1]]; \
        asm volatile("s_waitcnt vmcnt(0)" : "+v"(x0), "+v"(x1), "+v"(x2), "+v"(x3) :: "memory"); }     \
        dst[0][0] = x0 + gC[0]; dst[0][1] = x1 + gC[1]; dst[1][0] = x2 + gC[0]; dst[1][1] = x3 + gC[1]; } while (0)
    const unsigned ldsw = (unsigned)wid * 1024u;
    const int aoff = lds_byte(wr * 64 + fr, fq * 8), boff = lds_byte(wc * 32 + fr, fq * 8);
    int boffB = boff + 4 * HTB; if constexpr (FP8) asm volatile("" : "+v"(boffB));
#define PG8_SA(b, h) (((b) * 2 + (h)) * HTB)
#define PG8_SB(b, h) ((4 + (b) * 2 + (h)) * HTB)
#define PG8_STAGE(bufoff, gbase, voff) do { const char* gb_ = (const char*)(gbase); if constexpr (FP8) asm volatile("" : "+s"(gb_)); _Pragma("unroll") for (int _i = 0; _i < 2; ++_i) { \
        unsigned vo_ = (voff)[_i]; if constexpr (FP8) asm volatile("" : "+v"(vo_)); \
        __builtin_amdgcn_global_load_lds((const unsigned*)(gb_ + vo_), (PG8_LAS unsigned*)(lds + (bufoff) + ldsw + _i * 8192), 16, 0, 0); } } while (0)
#define PG8_AH1(p_) (GATHER ? (p_) : (p_) + hstep)
#define PG8_VH1(v_) (GATHER ? v_[1] : v_[0])
#define PG8_LDA8(dst, b, h) do { _Pragma("unroll") for (int m = 0; m < 4; ++m) dst[m] = PG8_CAT(*(const PG8_LAS bf16x8*)(lds + PG8_SA(b, h) + aoff + m * 2048), *(const PG8_LAS bf16x8*)(lds + PG8_SA(b, h) + aoff + m * 2048 + 1024)); } while (0)
#define PG8_LDB8(dst, b, h) do { _Pragma("unroll") for (int n = 0; n < 2; ++n) dst[n] = PG8_CAT(*(const PG8_LAS bf16x8*)(lds + boffB + ((b) * 2 + (h)) * HTB + n * 2048), *(const PG8_LAS bf16x8*)(lds + boffB + ((b) * 2 + (h)) * HTB + n * 2048 + 1024)); } while (0)
#define PG8_LDA(dst, b, h) do { if constexpr (FP8) { PG8_LDA8(dst##8, b, h); } else { _Pragma("unroll") for (int m = 0; m < 4; ++m) _Pragma("unroll") for (int k = 0; k < 2; ++k) dst[m][k] = *(const PG8_LAS bf16x8*)(lds + PG8_SA(b, h) + aoff + m * 2048 + k * 1024); } } while (0)
#define PG8_LDB(dst, b, h) do { if constexpr (FP8) { PG8_LDB8(dst##8, b, h); } else { _Pragma("unroll") for (int n = 0; n < 2; ++n) _Pragma("unroll") for (int k = 0; k < 2; ++k) dst[n][k] = *(const PG8_LAS bf16x8*)(lds + PG8_SB(b, h) + boff + n * 2048 + k * 1024); } } while (0)
#define PG8_CAT(x, y) __builtin_bit_cast(v8i32, __builtin_shufflevector(x, y, 0, 1, 2, 3, 4, 5, 6, 7, 8, 9, 10, 11, 12, 13, 14, 15))
#define PG8_MMA(ai, bj, At, Bt) do { __builtin_amdgcn_s_setprio(1); _Pragma("unroll") for (int m = 0; m < 4; ++m) _Pragma("unroll") for (int n = 0; n < 2; ++n) { \
        if constexpr (FP8) acc[ai][bj][m][n] = __builtin_amdgcn_mfma_scale_f32_16x16x128_f8f6f4(Bt##8[n], At##8[m], acc[ai][bj][m][n], 0, 0, 0, 0x7f7f7f7f, 0, 0x7f7f7f7f); \
        else { _Pragma("unroll") for (int k = 0; k < 2; ++k) acc[ai][bj][m][n] = __builtin_amdgcn_mfma_f32_16x16x32_bf16(Bt[n][k], At[m][k], acc[ai][bj][m][n], 0, 0, 0); } } __builtin_amdgcn_s_setprio(0); } while (0)
#define PG8_WAIT_V(n) asm volatile("s_waitcnt vmcnt(" #n ")" ::: "memory")
#define PG8_WAIT_L(n) asm volatile("s_waitcnt lgkmcnt(" #n ")" ::: "memory")
#define PG8_BAR __builtin_amdgcn_s_barrier()
#define PG8_SCHED do { if constexpr (!FP8) __builtin_amdgcn_sched_barrier(0); } while (0)
    Unit cur, nxt; int ui = 0;
    if (!S.next(0, cur)) return;
    f32x4 acc[2][2][4][2];
#pragma unroll
    for (int a = 0; a < 2; ++a)
#pragma unroll
        for (int b = 0; b < 2; ++b)
#pragma unroll
            for (int m = 0; m < 4; ++m)
#pragma unroll
                for (int n = 0; n < 2; ++n) acc[a][b][m][n] = (f32x4){0.f, 0.f, 0.f, 0.f};
    bf16x8 At[4][2], B0[2][2], B1[2][2]; v8i32 At8[4], B08[2], B18[2];
    const char* cA = cur.A; const char* cB = cur.B;
    if constexpr (GATHER) { PG8_ROWS(vA, cur); }
    S.a_ready(cur);
    if constexpr (SP2) {
        PG8_STAGE(PG8_SB(0, 0), cB, voffB); PG8_STAGE(PG8_SB(0, 1), cB + hstep, voffB); PG8_STAGE(PG8_SA(0, 0), cA, vA[0]); PG8_STAGE(PG8_SA(0, 1), PG8_AH1(cA), PG8_VH1(vA));
        if (wr == 1) PG8_BAR;
        PG8_WAIT_V(2); PG8_BAR;
        PG8_STAGE(PG8_SB(1, 0), cB + kstep, voffB); PG8_STAGE(PG8_SA(1, 0), cA + kstep, vA[0]); PG8_STAGE(PG8_SB(1, 1), cB + hstep + kstep, voffB);
        PG8_WAIT_V(6); PG8_BAR;
    } else {
        PG8_STAGE(PG8_SB(0, 0), cB, voffB); PG8_STAGE(PG8_SA(0, 0), cA, vA[0]); PG8_STAGE(PG8_SB(0, 1), cB + hstep, voffB); PG8_STAGE(PG8_SA(0, 1), PG8_AH1(cA), PG8_VH1(vA));
        if (wr == 1) PG8_BAR;
        PG8_WAIT_V(4); PG8_BAR;
        PG8_STAGE(PG8_SB(1, 0), cB + kstep, voffB); PG8_STAGE(PG8_SA(1, 0), cA + kstep, vA[0]); PG8_STAGE(PG8_SB(1, 1), cB + hstep + kstep, voffB);
        PG8_WAIT_V(6); PG8_BAR;
    }
    for (;;) {
        const bool has_next = S.next(ui + 1, nxt);
        const char* nA = has_next ? nxt.A : cA; const char* nB = has_next ? nxt.B : cB;
        if constexpr (GATHER) { if (has_next) { PG8_ROWS(vAn, nxt); } else { vAn[0][0] = vA[0][0]; vAn[0][1] = vA[0][1]; vAn[1][0] = vA[1][0]; vAn[1][1] = vA[1][1]; } }
        for (int t = 0; t < nt; t += 2) {
            const bool last = (t == nt - 2);
            const char* a1 = cA + (size_t)(t + 1) * kstep;
            const char* a2 = last ? nA : cA + (size_t)(t + 2) * kstep; const char* b2 = last ? nB : cB + (size_t)(t + 2) * kstep;
            const char* a3 = a2 + kstep; const char* b3 = b2 + kstep;
            unsigned vX[2][2];
#pragma unroll
            for (int h = 0; h < 2; ++h)
#pragma unroll
                for (int i = 0; i < 2; ++i) vX[h][i] = (GATHER && last) ? vAn[h][i] : vA[h][i];
            if (last && has_next) S.a_ready(nxt);
            if constexpr (SP2) {
            PG8_LDB(B0, 0, 0); PG8_LDB(B1, 0, 1); PG8_SCHED; PG8_LDA(At, 0, 0); PG8_STAGE(PG8_SA(1, 1), PG8_AH1(a1), PG8_VH1(vA));
            PG8_WAIT_V(8); PG8_WAIT_L(0); PG8_BAR; PG8_MMA(0, 0, At, B0); PG8_MMA(0, 1, At, B1); PG8_BAR; PG8_SCHED;
            PG8_LDA(At, 0, 1); PG8_STAGE(PG8_SB(0, 0), b2, voffB); PG8_STAGE(PG8_SB(0, 1), b2 + hstep, voffB); PG8_STAGE(PG8_SA(0, 0), a2, vX[0]);
            PG8_WAIT_V(8); PG8_WAIT_L(0); PG8_BAR; PG8_MMA(1, 0, At, B0); PG8_MMA(1, 1, At, B1); PG8_BAR; PG8_SCHED;
            PG8_LDB(B0, 1, 0); PG8_LDB(B1, 1, 1); PG8_SCHED; PG8_LDA(At, 1, 0); PG8_STAGE(PG8_SA(0, 1), PG8_AH1(a2), PG8_VH1(vX));
            PG8_WAIT_V(8); PG8_WAIT_L(0); PG8_BAR; PG8_MMA(0, 0, At, B0); PG8_MMA(0, 1, At, B1); PG8_BAR; PG8_SCHED;
            PG8_LDA(At, 1, 1); PG8_STAGE(PG8_SB(1, 0), b3, voffB); PG8_STAGE(PG8_SB(1, 1), b3 + hstep, voffB); PG8_STAGE(PG8_SA(1, 0), a3, vX[0]);
            PG8_WAIT_V(8); PG8_WAIT_L(0); PG8_BAR; PG8_MMA(1, 0, At, B0); PG8_MMA(1, 1, At, B1); PG8_BAR; PG8_SCHED;
            } else {
            PG8_LDB(B0, 0, 0); PG8_SCHED; PG8_LDA(At, 0, 0); PG8_STAGE(PG8_SA(1, 1), PG8_AH1(a1), PG8_VH1(vA));
            PG8_WAIT_L(8); PG8_BAR; PG8_WAIT_L(0); PG8_MMA(0, 0, At, B0); PG8_BAR; PG8_SCHED;
            PG8_LDB(B1, 0, 1); PG8_STAGE(PG8_SB(0, 0), b2, voffB);
            PG8_BAR; PG8_WAIT_L(0); PG8_MMA(0, 1, At, B1); PG8_BAR;
            PG8_LDA(At, 0, 1); PG8_STAGE(PG8_SA(0, 0), a2, vX[0]);
            PG8_BAR; PG8_WAIT_L(0); PG8_MMA(1, 0, At, B0); PG8_BAR; PG8_SCHED;
            PG8_STAGE(PG8_SB(0, 1), b2 + hstep, voffB);
            PG8_WAIT_V(6); PG8_BAR; PG8_MMA(1, 1, At, B1); PG8_BAR;
            PG8_LDB(B0, 1, 0); PG8_SCHED; PG8_LDA(At, 1, 0); PG8_STAGE(PG8_SA(0, 1), PG8_AH1(a2), PG8_VH1(vX));
            PG8_WAIT_L(8); PG8_BAR; PG8_WAIT_L(0); PG8_MMA(0, 0, At, B0); PG8_BAR; PG8_SCHED;
            PG8_LDB(B1, 1, 1); PG8_STAGE(PG8_SB(1, 0), b3, voffB);
            PG8_BAR; PG8_WAIT_L(0); PG8_MMA(0, 1, At, B1); PG8_BAR;
            PG8_LDA(At, 1, 1); PG8_STAGE(PG8_SA(1, 0), a3, vX[0]);
            PG8_BAR; PG8_WAIT_L(0); PG8_MMA(1, 0, At, B0); PG8_BAR; PG8_SCHED;
            PG8_STAGE(PG8_SB(1, 1), b3 + hstep, voffB);
            PG8_WAIT_V(6); PG8_BAR; PG8_MMA(1, 1, At, B1); PG8_BAR;
            }
        }
        if constexpr (ALIGN_EPI) { if (wr == 0) PG8_BAR; }
        bool chained = false;
        if constexpr (Epi::CHAIN) chained = E.mid(acc, cur, wr, wc, fr, fq);
        if (!chained) { if constexpr (!Epi::AFTER_DRAIN) {
            if constexpr (FP8) { int l2; asm volatile("v_mbcnt_lo_u32_b32 %0, -1, 0\n\tv_mbcnt_hi_u32_b32 %0, -1, %0" : "=v"(l2));
                E(acc, cur, wr, wc, l2 & 15, l2 >> 4); }
            else E(acc, cur, wr, wc, fr, fq);
            S.done(cur); } }
        if (!has_next) break;
        if (!chained) {
#pragma unroll
        for (int a = 0; a < 2; ++a)
#pragma unroll
            for (int b = 0; b < 2; ++b)
#pragma unroll
                for (int m = 0; m < 4; ++m)
#pragma unroll
                    for (int n = 0; n < 2; ++n) acc[a][b][m][n] = (f32x4){0.f, 0.f, 0.f, 0.f};
        }
        cur = nxt; cA = nA; cB = nB; ++ui;
        if constexpr (GATHER) { vA[0][0] = vAn[0][0]; vA[0][1] = vAn[0][1]; vA[1][0] = vAn[1][0]; vA[1][1] = vAn[1][1]; }
        if constexpr (ALIGN_EPI) { if (wr == 1) PG8_BAR; }
    }
    PG8_WAIT_V(0);
    if constexpr (!ALIGN_EPI) { if (wr == 0) PG8_BAR; }
    PG8_BAR;
    if constexpr (Epi::AFTER_DRAIN) { E.fused(acc, cur, wr, wc, fr, fq, lds, wid, lane); S.done(cur); }
#undef PG8_SA
#undef PG8_ROWS
#undef PG8_SB
#undef PG8_STAGE
#undef PG8_LDA
#undef PG8_LDA8
#undef PG8_AH1
#undef PG8_VH1
#undef PG8_LDB8
#undef PG8_LDB
#undef PG8_MMA
#undef PG8_CAT
#undef PG8_WAIT_V
#undef PG8_WAIT_L
#undef PG8_BAR
#undef PG8_SCHED
}
}
#define LAS __attribute__((address_space(3)))
#define GAS __attribute__((address_space(1)))
typedef unsigned short bf16;
typedef unsigned v4u __attribute__((ext_vector_type(4)));
typedef unsigned v2u __attribute__((ext_vector_type(2)));
typedef float f32x4 __attribute__((ext_vector_type(4)));
typedef float f32x2 __attribute__((ext_vector_type(2)));
typedef short bf16x8 __attribute__((ext_vector_type(8)));

namespace mk {
constexpr int D = 1024, NB_ = 8, S = 4096, T = NB_ * S;
constexpr int INW = 5120, NCAT = 7168;
constexpr int H = 8, DH = 128, NBLK = 16;
constexpr int XH = 4, XW = 512, MEM = 256;
constexpr int NE = 64, EH = 512;
constexpr int MAXTILES = 320;
constexpr int MAXSLOTS = MAXTILES * 256;
constexpr float EPS = 1e-6f;
constexpr int NWAVES = 8, NTHREADS = 512;

constexpr size_t MiB = 1u << 20;
constexpr size_t WS_U    = 0;
constexpr size_t WS_GV   = 64 * MiB;
constexpr size_t WS_Q    = 128 * MiB;
constexpr size_t WS_V    = 192 * MiB;
constexpr size_t WS_K    = 256 * MiB;
constexpr size_t WS_G    = 320 * MiB;
constexpr size_t WS_W    = 448 * MiB;
constexpr size_t W_CAT = WS_W, W_A = W_CAT + 14 * MiB, W_B = W_A + 2 * MiB, W_O = W_B + 2 * MiB, W_XQ = W_O + 2 * MiB, W_XKV = W_XQ + 1 * MiB,
                 W_XO = W_XKV + 2 * MiB, W_R = W_XO + 1 * MiB, W_END = W_R + 1 * MiB;
constexpr size_t WS_KVM  = W_END;
constexpr size_t WS_KPART = WS_KVM + 4 * MiB;
constexpr size_t WS_VSTAT = WS_KPART + 1 * MiB;
constexpr size_t WS_ST1  = WS_VSTAT + 2 * MiB;
constexpr size_t WS_ST2  = WS_ST1 + 2 * MiB;
constexpr size_t WS_RL   = WS_ST2 + 2 * MiB;
constexpr size_t WS_WSP  = WS_RL + 16 * MiB;
constexpr size_t WS_BTAB = WS_WSP + 256 * 1024;
constexpr size_t WS_CTL  = WS_BTAB + 4096;
constexpr size_t WS_EID  = WS_CTL + 4096;
constexpr size_t WS_WT   = WS_EID + 256 * 1024;
constexpr size_t WS_PSLOT = WS_WT + 256 * 1024;
constexpr size_t WS_SLOTP = WS_PSLOT + 256 * 1024;
constexpr size_t WS_SLOTRS = WS_SLOTP + 512 * 1024;
constexpr size_t WS_SLOTOFF = WS_SLOTRS + 512 * 1024;
constexpr size_t WS_BAR  = WS_SLOTOFF + 512 * 1024;
constexpr size_t WS_END  = WS_BAR + 16384;
static_assert(WS_END <= 512 * MiB, "workspace map");
constexpr size_t WS_MERGED = WS_GV;
constexpr size_t WS_HB   = WS_K;
constexpr size_t WS_Q2   = WS_V;
constexpr size_t WS_WGU  = WS_G;
constexpr size_t WS_XG8  = WS_U + 32 * MiB;
constexpr float WGU_SCALE = 64.f, WD_SCALE = 32.f, HDN_SCALE = 4.f, Y_SCALE = 16.f;
constexpr size_t WS_XG   = WS_GV;
constexpr size_t WS_Y    = WS_GV;
constexpr size_t OUT_XN = 0;
constexpr size_t OUT_MEMN = 64 * MiB;
constexpr size_t OUT_WD  = 72 * MiB;
constexpr size_t OUT_HDN = 0;

constexpr int RING_BYTES = 131072;
constexpr int LDS_MISC = RING_BYTES;
constexpr int LDS_BYTES = 147456;

struct Params {
    const float *x, *mem, *norm_mix, *w_in, *w_gate, *b_gate, *sgu_norm, *w_spatial, *b_spatial, *w_branch_a, *w_branch_b, *rel_bias, *w_o, *norm_x, *norm_mem,
        *w_xq, *w_xkv, *w_xo, *norm_ffn, *w_rg, *b_rg, *w_re, *b_re, *w_e_gate, *w_e_up, *w_e_down, *norm_final;
    float* out; unsigned char* ws;
    int ph_lo, ph_hi;
};
typedef const Params __attribute__((address_space(4)))* PPtr;

__device__ __forceinline__ unsigned f2bf(float f) { unsigned u = __builtin_bit_cast(unsigned, f); return (u + 0x7fffu + ((u >> 16) & 1u)) >> 16; }
typedef __bf16 bf16x2_t __attribute__((ext_vector_type(2)));
__device__ __forceinline__ unsigned pk2(float lo, float hi) { const f32x2 v = {lo, hi}; const bf16x2_t b = __builtin_convertvector(v, bf16x2_t); return __builtin_bit_cast(unsigned, b); }
__device__ __forceinline__ unsigned pk4_fp8(float a, float b, float c, float d) { unsigned w = 0; w = __builtin_amdgcn_cvt_pk_fp8_f32(a, b, w, false); w = __builtin_amdgcn_cvt_pk_fp8_f32(c, d, w, true); return w; }
__device__ __forceinline__ f32x4 unpk4_fp8(unsigned w) { const f32x2 lo = __builtin_amdgcn_cvt_pk_f32_fp8(w, false), hi = __builtin_amdgcn_cvt_pk_f32_fp8(w, true); return (f32x4){lo.x, lo.y, hi.x, hi.y}; }
__device__ __forceinline__ unsigned pk4_u8(f32x4 g) {
    const unsigned q0 = (unsigned)(g[0] * 255.f + 0.5f), q1 = (unsigned)(g[1] * 255.f + 0.5f), q2 = (unsigned)(g[2] * 255.f + 0.5f), q3 = (unsigned)(g[3] * 255.f + 0.5f);
    return q0 | (q1 << 8) | (q2 << 16) | (q3 << 24); }
__device__ __forceinline__ f32x4 unpk4_u8(unsigned w) { return (f32x4){(float)(w & 0xffu), (float)((w >> 8) & 0xffu), (float)((w >> 16) & 0xffu), (float)(w >> 24)}; }
__device__ __forceinline__ float bf2f(unsigned short b) { return __builtin_bit_cast(float, (unsigned)b << 16); }
__device__ __forceinline__ float bflo(unsigned w) { return __builtin_bit_cast(float, w << 16); }
__device__ __forceinline__ float bfhi(unsigned w) { return __builtin_bit_cast(float, w & 0xffff0000u); }
__device__ __forceinline__ float wave_sum(float v) {
#pragma unroll
    for (int o = 1; o < 64; o <<= 1) v += __shfl_xor(v, o);
    return v;
}
__device__ __forceinline__ float fast_exp2(float x) { return __builtin_amdgcn_exp2f(x); }
__device__ __forceinline__ float fast_rcp(float x) { return __builtin_amdgcn_rcpf(x); }
__device__ __forceinline__ float gelu_tanh(float x) {
    const float k = -2.0f * 0.7978845608028654f * 1.4426950408889634f;
    const float u = x * (1.0f + 0.044715f * x * x);
    return x * fast_rcp(1.0f + fast_exp2(k * u));
}
__device__ __forceinline__ float sigmoid_f(float x) { return fast_rcp(1.0f + fast_exp2(-1.4426950408889634f * x)); }
}
namespace mk {
struct TrItem { const float* src; int ldn, k0, n0; bf16* dst; int ldk, drow; const float* kscale; bool nt; float fp8 = 0.f; };
__device__ __forceinline__ void tr_load(const TrItem& it, f32x4 (&v)[16], int lane) {
    const float* sp = it.src + (size_t)(it.k0 + (lane >> 4)) * it.ldn + it.n0 + 4 * (lane & 15);
#pragma unroll
    for (int i = 0; i < 16; ++i) v[i] = *(const f32x4*)(sp + (size_t)(4 * i) * it.ldn);
}
__device__ __forceinline__ void tr_store(const TrItem& it, const f32x4 (&v)[16], LAS float* scr, int lane) {
#pragma unroll
    for (int i = 0; i < 16; ++i) {
        const int kk = (lane >> 4) + 4 * i;
        f32x4 x = v[i];
        if (it.kscale) x = x * it.kscale[it.k0 + kk];
        if (it.fp8 != 0.f) x = x * it.fp8;
        LAS float* d = scr + kk * 65 + 4 * (lane & 15);
        d[0] = x.x; d[1] = x.y; d[2] = x.z; d[3] = x.w;
    }
    asm volatile("s_waitcnt lgkmcnt(0)" ::: "memory");
    if (it.fp8 != 0.f) {
#pragma unroll
        for (int j = 0; j < 4; ++j) {
            const int q = lane + 64 * j, n = q >> 2, c = q & 3;
            const LAS float* s = scr + (16 * c) * 65 + n;
            v4u o; o.x = pk4_fp8(s[0], s[65], s[2 * 65], s[3 * 65]); o.y = pk4_fp8(s[4 * 65], s[5 * 65], s[6 * 65], s[7 * 65]); o.z = pk4_fp8(s[8 * 65], s[9 * 65], s[10 * 65], s[11 * 65]); o.w = pk4_fp8(s[12 * 65], s[13 * 65], s[14 * 65], s[15 * 65]);
            __builtin_nontemporal_store(o, (v4u*)((unsigned char*)it.dst + (size_t)(it.drow + n) * it.ldk + it.k0 + 16 * c));
        }
        asm volatile("s_waitcnt lgkmcnt(0)" ::: "memory");
        return;
    }
#pragma unroll
    for (int j = 0; j < 8; ++j) {
        const int q = lane + 64 * j, n = q >> 3, c = q & 7;
        const LAS float* s = scr + (8 * c) * 65 + n;
        v4u o; o.x = pk2(s[0], s[65]); o.y = pk2(s[2 * 65], s[3 * 65]); o.z = pk2(s[4 * 65], s[5 * 65]); o.w = pk2(s[6 * 65], s[7 * 65]);
        if (it.nt) __builtin_nontemporal_store(o, (v4u*)(it.dst + (size_t)(it.drow + n) * it.ldk + it.k0 + 8 * c)); else *(v4u*)(it.dst + (size_t)(it.drow + n) * it.ldk + it.k0 + 8 * c) = o;
    }
    asm volatile("s_waitcnt lgkmcnt(0)" ::: "memory");
}
template <class Make> __device__ __forceinline__ void tr_run(int first, int stride, int n_items, const Make& make, LAS float* scr, int lane) {
    if (first >= n_items) return;
    f32x4 va[16], vb[16];
    TrItem ia = make(first), ib = ia;
    tr_load(ia, va, lane);
    for (int r = first; r < n_items; r += 2 * stride) {
        const bool hb = r + stride < n_items;
        if (hb) { ib = make(r + stride); tr_load(ib, vb, lane); }
        tr_store(ia, va, scr, lane);
        if (!hb) break;
        const bool ha = r + 2 * stride < n_items;
        if (ha) { ia = make(r + 2 * stride); tr_load(ia, va, lane); }
        tr_store(ib, vb, scr, lane);
        if (!ha) break;
    }
}
struct TrMat { const float* src; int K, N; bf16* dst; int ldk, row_off; const float* kscale;
    __device__ __forceinline__ TrItem operator()(int r) const { const int nnb = N / 64, kb = r / nnb, nb = r % nnb; return TrItem{src, N, 64 * kb, 64 * nb, dst, ldk, row_off + 64 * nb, kscale, false}; } };
__device__ __forceinline__ void transpose_matrix(int& it, int gw, int NGW, const float* src, int K, int N, bf16* dst, int ldk, int row_off, const float* kscale, LAS float* scr, int lane) {
    const int n_items = (K / 64) * (N / 64);
    int first = gw - (it % NGW); if (first < 0) first += NGW;
    tr_run(first, NGW, n_items, TrMat{src, K, N, dst, ldk, row_off, kscale}, scr, lane);
    it += n_items;
}
__device__ __forceinline__ void norm_row_bf16(const float* __restrict__ xrow, const float* __restrict__ g, bf16* __restrict__ orow, int lane) {
    const f32x4* xr = (const f32x4*)xrow + lane;
    f32x4 v[4]; float s = 0.f;
#pragma unroll
    for (int j = 0; j < 4; ++j) { v[j] = xr[64 * j]; s += (v[j].x * v[j].x + v[j].y * v[j].y) + (v[j].z * v[j].z + v[j].w * v[j].w); }
    const float rstd = rsqrtf(wave_sum(s) * (1.f / 1024.f) + EPS);
    v2u* o8 = (v2u*)orow + lane;
#pragma unroll
    for (int j = 0; j < 4; ++j) { const f32x4 gg = ((const f32x4*)g)[lane + 64 * j]; v2u w; w.x = pk2(v[j].x * rstd * gg.x, v[j].y * rstd * gg.y); w.y = pk2(v[j].z * rstd * gg.z, v[j].w * rstd * gg.w); o8[64 * j] = w; }
}
__device__ __forceinline__ int rel_bucket(int n) {
    if (n < 16) return n;
    const int large = 16 + (int)(logf((float)n / 16.0f) / 2.0794415416798357f * 16.0f);
    return large < 31 ? large : 31;
}

__device__ __forceinline__ void phase_prologue(PPtr p, LAS unsigned char* lds, int vcu, int G, const int tid) {
    const int lane = tid & 63, wave = tid >> 6;
    const int gw = vcu * NWAVES + wave, NGW = G * NWAVES;
    LAS float* scr = (LAS float*)(lds + wave * 16640);
    unsigned char* ws = p->ws;
    int it = 0;
    bf16* wcat = (bf16*)(ws + W_CAT);
    transpose_matrix(it, gw, NGW, p->w_in, D, INW, wcat, D, 0, nullptr, scr, lane);
    transpose_matrix(it, gw, NGW, p->w_gate, D, 2048, wcat, D, INW, nullptr, scr, lane);
    transpose_matrix(it, gw, NGW, p->w_branch_a, D, D, (bf16*)(ws + W_A), D, 0, nullptr, scr, lane);
    transpose_matrix(it, gw, NGW, p->w_branch_b, D, D, (bf16*)(ws + W_B), D, 0, nullptr, scr, lane);
    transpose_matrix(it, gw, NGW, p->w_o, D, D, (bf16*)(ws + W_O), D, 0, nullptr, scr, lane);
    transpose_matrix(it, gw, NGW, p->w_xq, D, XW, (bf16*)(ws + W_XQ), D, 0, p->norm_x, scr, lane);
    transpose_matrix(it, gw, NGW, p->w_xkv, D, 1024, (bf16*)(ws + W_XKV), D, 0, nullptr, scr, lane);
    transpose_matrix(it, gw, NGW, p->w_xo, XW, D, (bf16*)(ws + W_XO), XW, 0, nullptr, scr, lane);
    bf16* xn = (bf16*)((unsigned char*)p->out + OUT_XN); bf16* memn = (bf16*)((unsigned char*)p->out + OUT_MEMN);
    for (int m = gw; m < T; m += NGW) norm_row_bf16(p->x + (size_t)m * D, p->norm_mix, xn + (size_t)m * D, lane);
    for (int m = gw; m < NB_ * MEM; m += NGW) norm_row_bf16(p->mem + (size_t)m * D, p->norm_mem, memn + (size_t)m * D, lane);
    const int gt = vcu * NTHREADS + tid, NGT = G * NTHREADS;
    {
        bf16* wr = (bf16*)(ws + W_R);
        for (int i = gt; i < 256 * 1024; i += NGT) { const int n = i >> 10, k = i & 1023; float v = 0.f;
            if (n < 8) v = p->w_rg[k * 8 + n] * p->norm_ffn[k]; else if (n < 72) v = p->w_re[k * 64 + (n - 8)] * p->norm_ffn[k];
            wr[i] = (bf16)f2bf(v); }
    }
    {
        bf16* wsp = (bf16*)(ws + WS_WSP);
        for (int i = gt; i < 8 * 128 * 128; i += NGT) { const int t = (i >> 7) & 127, s = i & 127; wsp[i] = (bf16)f2bf(s <= t ? p->w_spatial[i] : 0.f); }
    }
    {
        float* bt = (float*)(ws + WS_BTAB);
        for (int i = gt; i < 8 * 128; i += NGT) { const int h = i >> 7, dist = i & 127; bt[i] = p->rel_bias[rel_bucket(dist) * H + h] * 11.313708498984761f; }
    }
    {   int* ctl = (int*)(ws + WS_CTL); for (int i = gt; i < 1024; i += NGT) ctl[i] = 0; }
}

struct TrGU { const float* wg; const float* wu; unsigned char* dst; const float* ns;
    __device__ __forceinline__ TrItem operator()(int r) const { const int nb = r & 7, kb = (r >> 3) & 15, which = (r >> 7) & 1, e = r >> 8;
        const float* base = (const float*)((uintptr_t)wg + (uintptr_t)which * ((uintptr_t)wu - (uintptr_t)wg));
        return TrItem{base + (size_t)e * D * EH, EH, 64 * kb, 64 * nb, (bf16*)(dst + (size_t)e * 1024 * D), D, (nb >> 1) * 256 + which * 128 + (nb & 1) * 64, ns, true, WGU_SCALE}; } };
struct TrD { const float* wd; unsigned char* dst;
    __device__ __forceinline__ TrItem operator()(int r) const { const int nb = r & 15, kb = (r >> 4) & 7, e = r >> 7;
        return TrItem{wd + (size_t)e * EH * D, D, 64 * kb, 64 * nb, (bf16*)(dst + (size_t)e * D * EH), EH, 64 * nb, nullptr, true, WD_SCALE}; } };
constexpr int WD_G1 = 4096, WD_EARLY = 2560;
__device__ __forceinline__ void phase_convert_experts(PPtr p, LAS unsigned char* lds, int vcu, int G, int part, const int tid, int wg0 = 0) {
    const int lane = tid & 63, wave = tid >> 6;
    const int gw = vcu * NWAVES + wave, NGW = G * NWAVES;
    LAS float* scr = (LAS float*)(lds + wave * 16640);
    unsigned char* wd8 = (unsigned char*)p->out + OUT_WD;
    if (part == 0) tr_run(gw, NGW, NE * 2 * 16 * 8, TrGU{p->w_e_gate, p->w_e_up, p->ws + WS_WGU, p->norm_ffn}, scr, lane);
    else if (part == 1) tr_run(WD_G1 + WD_EARLY + gw, NGW, NE * 8 * 16, TrD{p->w_e_down, wd8}, scr, lane);
    else { const int bx = blockIdx.x, lo = part == 3 ? 0 : WD_G1, hi = part == 3 ? WD_G1 : WD_G1 + WD_EARLY;
        if (bx >= wg0) tr_run(lo + (bx - wg0) * NWAVES + wave, (G - wg0) * NWAVES, hi, TrD{p->w_e_down, wd8}, scr, lane); }
}
}
namespace mk {
using pg8::Unit;
typedef const f32x4 (&AccRef)[2][2][4][2];

__device__ __forceinline__ void tile_order(int L, int nM, int nN, int& pm, int& pn) {
    const int nwg = nM * nN; int wgid = L;
    { const int q = nwg / 8, r = nwg % 8, xcd = wgid % 8, off = wgid / 8; wgid = (xcd < r ? xcd * (q + 1) : r * (q + 1) + (xcd - r) * q) + off; }
    const int nig = 8 * nN, gid = wgid / nig, fm = gid * 8, gsz = (nM - fm) < 8 ? (nM - fm) : 8;
    pm = fm + ((wgid % nig) % gsz); pn = (wgid % nig) / gsz;
}
struct SchedPlain {
    const char* A; const char* B; int nM, nN, G, c; size_t tstep;
    __device__ __forceinline__ bool next(int i, Unit& u) const {
        const long L = (long)i * G + c; if (L >= (long)nM * nN) return false;
        tile_order((int)L, nM, nN, u.pm, u.pn); u.A = A + (size_t)u.pm * tstep; u.B = B + (size_t)u.pn * tstep; u.aux = 0; return true; }
    __device__ __forceinline__ void a_ready(const Unit&) const {}
    __device__ __forceinline__ void done(const Unit&) const {}
};
struct SchedG1 {
    const char *A, *B, *A2, *B2; int G, c;
    __device__ __forceinline__ bool next(int i, Unit& u) const {
        const long L = (long)i * G + c; constexpr int N1 = 128 * 28; constexpr size_t ts = (size_t)256 * 1024 * 2;
        if (L < N1) { tile_order((int)L, 128, 28, u.pm, u.pn); u.A = A + (size_t)u.pm * ts; u.B = B + (size_t)u.pn * ts; u.aux = 0; return true; }
        if (L < N1 + 32) { const int l = (int)L - N1; u.pm = l >> 2; u.pn = l & 3; u.A = A2 + (size_t)u.pm * ts; u.B = B2 + (size_t)u.pn * ts; u.aux = 1; return true; }
        return false; }
    __device__ __forceinline__ void a_ready(const Unit&) const {}
    __device__ __forceinline__ void done(const Unit&) const {}
};
struct SchedG2 {
    const char *A0, *B0, *A1, *B1; int G, c;
    __device__ __forceinline__ bool next(int i, Unit& u) const {
        const int tile_i = i >> 1, pass = i & 1; const long L = (long)tile_i * G + c; if (L >= 128 * 4) return false;
        constexpr size_t ts = (size_t)256 * 1024 * 2;
        tile_order((int)L, 128, 4, u.pm, u.pn); u.A = (pass ? A1 : A0) + (size_t)u.pm * ts; u.B = (pass ? B1 : B0) + (size_t)u.pn * ts; u.aux = pass; return true; }
    __device__ __forceinline__ void a_ready(const Unit&) const {}
    __device__ __forceinline__ void done(const Unit&) const {}
};

#define EPI_ROWS(ai, m) (row0 + (ai) * 128 + (m) * 16)
__device__ __forceinline__ v4u pack8f(f32x4 a, f32x4 b) { v4u w; w.x = pk2(a[0], a[1]); w.y = pk2(a[2], a[3]); w.z = pk2(b[0], b[1]); w.w = pk2(b[2], b[3]); return w; }

static_assert(WS_U == 0 && WS_GV == 64 * MiB && WS_Q == 128 * MiB && WS_V == 192 * MiB && WS_K == 256 * MiB, "EpiG1 output offsets");
template <int PLAINP = 0> struct EpiG1T {
    static constexpr bool PERM = true, AFTER_DRAIN = false, CHAIN = false;
    unsigned char* ws; const float* b_gate;
    __device__ __forceinline__ void operator()(AccRef acc, const Unit& u, int wr, int wc, int fr, int fq) const {
        if (PLAINP == 2) {
#pragma unroll
            for (int ai = 0; ai < 2; ++ai)
#pragma unroll
                for (int bj = 0; bj < 2; ++bj)
#pragma unroll
                    for (int m = 0; m < 4; ++m)
#pragma unroll
                        for (int n = 0; n < 2; ++n) asm volatile("" :: "v"(acc[ai][bj][m][n]));
            return; }
        const int row0 = u.pm * 256 + wr * 64 + fr, cl = wc * 32 + 8 * fq;
        if (u.aux == 1) {
#pragma unroll
            for (int ai = 0; ai < 2; ++ai)
#pragma unroll
                for (int m = 0; m < 4; ++m)
#pragma unroll
                    for (int bj = 0; bj < 2; ++bj) __builtin_nontemporal_store(pack8f(acc[ai][bj][m][0], acc[ai][bj][m][1]), (v4u*)((bf16*)(ws + WS_KVM) + (size_t)EPI_ROWS(ai, m) * 1024 + u.pn * 256 + bj * 128 + cl));
            return;
        }
        const int pn = PLAINP ? 8 + (u.pn % 4) : u.pn;
        if (pn >= 4 && pn < 8) {
            bf16* O = (bf16*)(ws + WS_GV); const int c0 = (pn & 3) * 256 + cl; const bool stats = true;
            float* vstat = (float*)(ws + WS_VSTAT);
#pragma unroll
            for (int ai = 0; ai < 2; ++ai)
#pragma unroll
                for (int m = 0; m < 4; ++m) { float ss = 0.f;
#pragma unroll
                    for (int bj = 0; bj < 2; ++bj) { f32x4 a = acc[ai][bj][m][0], b = acc[ai][bj][m][1];
#pragma unroll
                        for (int j = 0; j < 4; ++j) { a[j] = gelu_tanh(a[j]); b[j] = gelu_tanh(b[j]); ss += a[j] * a[j] + b[j] * b[j]; }
                        __builtin_nontemporal_store(pack8f(a, b), (v4u*)(O + (size_t)EPI_ROWS(ai, m) * 1024 + c0 + bj * 128)); }
                    if (stats) { ss += __shfl_xor(ss, 16); ss += __shfl_xor(ss, 32); if (fq == 0) vstat[(size_t)EPI_ROWS(ai, m) * 16 + (pn - 4) * 4 + wc] = ss; } }
        } else if (pn < 20) {
            const int reg = pn >> 2;
            bf16* O = (bf16*)(ws + (size_t)(reg == 0 ? 0 : reg == 2 ? 2 : reg == 3 ? 4 : 3) * (64 * MiB)); const int c0 = (pn & 3) * 256 + cl;
            float* kpart = (float*)(ws + WS_KPART);
#pragma unroll
            for (int ai = 0; ai < 2; ++ai)
#pragma unroll
                for (int m = 0; m < 4; ++m)
#pragma unroll
                    for (int bj = 0; bj < 2; ++bj) __builtin_nontemporal_store(pack8f(acc[ai][bj][m][0], acc[ai][bj][m][1]), (v4u*)(O + (size_t)EPI_ROWS(ai, m) * 1024 + c0 + bj * 128));
            if (pn >= 12 && pn < 16) {
#pragma unroll
                for (int bj = 0; bj < 2; ++bj)
#pragma unroll
                    for (int n = 0; n < 2; ++n) { f32x4 s = acc[0][bj][0][n];
#pragma unroll
                        for (int m = 1; m < 4; ++m) s = s + acc[0][bj][m][n];
#pragma unroll
                        for (int m = 0; m < 4; ++m) s = s + acc[1][bj][m][n];
#pragma unroll
                        for (int j = 0; j < 4; ++j) { float v = s[j]; v += __shfl_xor(v, 1); v += __shfl_xor(v, 2); v += __shfl_xor(v, 4); v += __shfl_xor(v, 8); s[j] = v; }
                        if (fr == 0) *(f32x4*)(kpart + ((size_t)u.pm * 2 + wr) * 1024 + c0 + bj * 128 + 4 * n) = s; }
            }
        } else {
            const int c0 = (pn - 20) * 256 + cl;
#pragma unroll
            for (int bj = 0; bj < 2; ++bj) { const f32x4 b0 = *(const f32x4*)(b_gate + c0 + bj * 128), b1 = *(const f32x4*)(b_gate + c0 + bj * 128 + 4);
#pragma unroll
                for (int ai = 0; ai < 2; ++ai)
#pragma unroll
                    for (int m = 0; m < 4; ++m) { f32x4 a = acc[ai][bj][m][0] + b0, b = acc[ai][bj][m][1] + b1;
#pragma unroll
                        for (int j = 0; j < 4; ++j) { a[j] = sigmoid_f(a[j]); b[j] = sigmoid_f(b[j]); }
                        v2u w8; w8.x = pk4_u8(a); w8.y = pk4_u8(b);
                        __builtin_nontemporal_store(w8, (v2u*)(ws + WS_G + (size_t)EPI_ROWS(ai, m) * 2048 + c0 + bj * 128)); } }
        }
    }
};
typedef EpiG1T<0> EpiG1;
struct EpiG2 {
    static constexpr bool PERM = true, AFTER_DRAIN = false, CHAIN = true;
    const unsigned char* Gt; bf16* MG;
    __device__ __forceinline__ bool mid(f32x4 (&acc)[2][2][4][2], const Unit& u, int wr, int wc, int fr, int fq) const {
        if (u.aux != 0) return false;
        const int row0 = u.pm * 256 + wr * 64 + fr, c0 = u.pn * 256 + wc * 32 + 8 * fq;
#pragma unroll
        for (int ai = 0; ai < 2; ++ai) {
            v2u g0[4][2], g1[4][2];
#pragma unroll
            for (int m = 0; m < 4; ++m)
#pragma unroll
                for (int bj = 0; bj < 2; ++bj) { const size_t r = (size_t)EPI_ROWS(ai, m); g0[m][bj] = *(const v2u*)(Gt + r * 2048 + c0 + bj * 128); g1[m][bj] = *(const v2u*)(Gt + r * 2048 + 1024 + c0 + bj * 128); }
#pragma unroll
            for (int m = 0; m < 4; ++m)
#pragma unroll
                for (int bj = 0; bj < 2; ++bj) {
#pragma unroll
                    for (int n = 0; n < 2; ++n) { const f32x4 q0 = unpk4_u8(n ? g0[m][bj].y : g0[m][bj].x), q1 = unpk4_u8(n ? g1[m][bj].y : g1[m][bj].x);
#pragma unroll
                        for (int j = 0; j < 4; ++j) acc[ai][bj][m][n][j] *= q0[j] * fast_rcp(fmaxf(q1[j], 1e-30f)); } }
        }
        return true;
    }
    __device__ __forceinline__ void operator()(AccRef acc, const Unit& u, int wr, int wc, int fr, int fq) const {
        const int row0 = u.pm * 256 + wr * 64 + fr, c0 = u.pn * 256 + wc * 32 + 8 * fq;
        v2u gg[2][4][2];
#pragma unroll
        for (int ai = 0; ai < 2; ++ai)
#pragma unroll
            for (int m = 0; m < 4; ++m)
#pragma unroll
                for (int bj = 0; bj < 2; ++bj) gg[ai][m][bj] = *(const v2u*)(Gt + (size_t)EPI_ROWS(ai, m) * 2048 + 1024 + c0 + bj * 128);
#pragma unroll
        for (int ai = 0; ai < 2; ++ai)
#pragma unroll
            for (int m = 0; m < 4; ++m)
#pragma unroll
                for (int bj = 0; bj < 2; ++bj) { const size_t r = (size_t)EPI_ROWS(ai, m); const v2u g = gg[ai][m][bj];
                    const f32x4 qa = unpk4_u8(g.x), qb = unpk4_u8(g.y);
                    f32x4 a = acc[ai][bj][m][0], b = acc[ai][bj][m][1];
#pragma unroll
                    for (int j = 0; j < 4; ++j) { a[j] *= fmaxf(qa[j], 1e-30f) * (1.0f / 255.0f); b[j] *= fmaxf(qb[j], 1e-30f) * (1.0f / 255.0f); }
                    *(v4u*)(MG + r * 1024 + c0 + bj * 128) = pack8f(a, b); }
    }
};
template <bool BASE_F32, bool OUT8 = false> struct EpiRes {
    static constexpr bool PERM = true, AFTER_DRAIN = false, CHAIN = false;
    const float* basef; bf16* HB; float* stat; bf16* HO; unsigned char* X8;
    __device__ __forceinline__ void operator()(AccRef acc, const Unit& u, int wr, int wc, int fr, int fq) const {
        const int row0 = u.pm * 256 + wr * 64 + fr, c0 = u.pn * 256 + wc * 32 + 8 * fq;
#pragma unroll
        for (int ai = 0; ai < 2; ++ai) {
            f32x4 ba[4][2][2]; v4u bw[4][2];
#pragma unroll
            for (int m = 0; m < 4; ++m)
#pragma unroll
                for (int bj = 0; bj < 2; ++bj) { const size_t o = (size_t)EPI_ROWS(ai, m) * 1024 + c0 + bj * 128;
                    if constexpr (BASE_F32) { ba[m][bj][0] = *(const f32x4*)(basef + o); ba[m][bj][1] = *(const f32x4*)(basef + o + 4); } else { bw[m][bj] = *(const v4u*)(HB + o); } }
#pragma unroll
            for (int m = 0; m < 4; ++m) { const size_t r = (size_t)EPI_ROWS(ai, m); float ss = 0.f;
#pragma unroll
                for (int bj = 0; bj < 2; ++bj) { const size_t o = r * 1024 + c0 + bj * 128;
                    f32x4 a, b;
                    if constexpr (BASE_F32) { a = ba[m][bj][0]; b = ba[m][bj][1]; }
                    else { const v4u w = bw[m][bj]; a = (f32x4){bflo(w.x), bfhi(w.x), bflo(w.y), bfhi(w.y)}; b = (f32x4){bflo(w.z), bfhi(w.z), bflo(w.w), bfhi(w.w)}; }
                    a = a + acc[ai][bj][m][0]; b = b + acc[ai][bj][m][1];
                    *(v4u*)(HO + o) = pack8f(a, b);
                    if constexpr (OUT8) { v2u w8; w8.x = pk4_fp8(a[0], a[1], a[2], a[3]); w8.y = pk4_fp8(b[0], b[1], b[2], b[3]); *(v2u*)(X8 + o) = w8; }
                    ss += (a[0] * a[0] + a[1] * a[1]) + (a[2] * a[2] + a[3] * a[3]) + (b[0] * b[0] + b[1] * b[1]) + (b[2] * b[2] + b[3] * b[3]); }
                ss += __shfl_xor(ss, 16); ss += __shfl_xor(ss, 32); if (fq == 0) stat[r * 16 + u.pn * 4 + wc] = ss; }
        }
    }
};
__device__ __forceinline__ float row_rstd(const float* stat, size_t r) {
    const f32x4* s = (const f32x4*)(stat + r * 16); const f32x4 a = s[0], b = s[1], c = s[2], d = s[3];
    const float t = ((a[0] + a[1]) + (a[2] + a[3])) + ((b[0] + b[1]) + (b[2] + b[3])) + ((c[0] + c[1]) + (c[2] + c[3])) + ((d[0] + d[1]) + (d[2] + d[3]));
    return rsqrtf(t * (1.0f / 1024.0f) + EPS);
}
struct EpiScaleBf16 {
    static constexpr bool PERM = true, AFTER_DRAIN = false, CHAIN = false;
    bf16* O; int ldo; const float* stat;
    __device__ __forceinline__ void operator()(AccRef acc, const Unit& u, int wr, int wc, int fr, int fq) const {
        const int row0 = u.pm * 256 + wr * 64 + fr, c0 = u.pn * 256 + wc * 32 + 8 * fq;
        float rsv[8];
#pragma unroll
        for (int k = 0; k < 8; ++k) rsv[k] = row_rstd(stat, (size_t)EPI_ROWS(k >> 2, k & 3));
#pragma unroll
        for (int ai = 0; ai < 2; ++ai)
#pragma unroll
            for (int m = 0; m < 4; ++m) { const size_t r = (size_t)EPI_ROWS(ai, m); const float rs = rsv[ai * 4 + m];
#pragma unroll
                for (int bj = 0; bj < 2; ++bj) *(v4u*)(O + r * ldo + c0 + bj * 128) = pack8f(acc[ai][bj][m][0] * rs, acc[ai][bj][m][1] * rs); }
    }
};
struct EpiRouter {
    static constexpr bool PERM = true, AFTER_DRAIN = false, CHAIN = false;
    float* RL; const float* stat;
    __device__ __forceinline__ void operator()(AccRef acc, const Unit& u, int wr, int wc, int fr, int fq) const {
        const int row0 = u.pm * 256 + wr * 64 + fr, c0 = wc * 32 + 8 * fq;
        float rsv[8];
#pragma unroll
        for (int k = 0; k < 8; ++k) rsv[k] = row_rstd(stat, (size_t)EPI_ROWS(k >> 2, k & 3));
#pragma unroll
        for (int ai = 0; ai < 2; ++ai)
#pragma unroll
            for (int m = 0; m < 4; ++m) { const size_t r = (size_t)EPI_ROWS(ai, m); const float rs = rsv[ai * 4 + m];
                *(f32x4*)(RL + r * 128 + c0) = acc[ai][0][m][0] * rs; *(f32x4*)(RL + r * 128 + c0 + 4) = acc[ai][0][m][1] * rs; }
    }
};
}
namespace mk {
typedef float f32x16 __attribute__((ext_vector_type(16)));
template <int NT> __device__ __forceinline__ void wave_mma_rows(const bf16* __restrict__ A, int lda, const bf16* __restrict__ Bt, int ldb, int K, f32x16 (&acc)[NT], int lane) {
    const int r32 = lane & 31, hi = lane >> 5;
    const bf16* ap = A + (size_t)r32 * lda + hi * 8; const bf16* bp = Bt + (size_t)r32 * ldb + hi * 8;
#pragma unroll
    for (int j = 0; j < NT; ++j)
#pragma unroll
        for (int r = 0; r < 16; ++r) acc[j][r] = 0.f;
#pragma unroll 16
    for (int k = 0; k < K; k += 16) {
        const bf16x8 a = *(const bf16x8*)(ap + k);
#pragma unroll
        for (int j = 0; j < NT; ++j) { const bf16x8 b = *(const bf16x8*)(bp + (size_t)(32 * j) * ldb + k); acc[j] = __builtin_amdgcn_mfma_f32_32x32x16_bf16(b, a, acc[j], 0, 0, 0); }
    }
}
__device__ __forceinline__ void phase_memkv(PPtr p, int vcu, int G, const int tid) {
    const int lane = tid & 63, wave = tid >> 6, r32 = lane & 31, hi = lane >> 5; const int gw = vcu * NWAVES + wave, NGW = G * NWAVES;
    const bf16* memn = (const bf16*)((const unsigned char*)p->out + OUT_MEMN); const bf16* w = (const bf16*)(p->ws + W_XKV); bf16* kvm = (bf16*)(p->ws + WS_KVM);
    for (int it = gw; it < 64 * 32; it += NGW) {
        const int rg = it >> 5, cg = it & 31;
        f32x16 acc[1];
        wave_mma_rows<1>(memn + (size_t)(32 * rg) * 1024, 1024, w + (size_t)(32 * cg) * 1024, 1024, 1024, acc, lane);
#pragma unroll
        for (int q = 0; q < 4; ++q) { v2u o; o.x = pk2(acc[0][4 * q], acc[0][4 * q + 1]); o.y = pk2(acc[0][4 * q + 2], acc[0][4 * q + 3]);
            *(v2u*)(kvm + (size_t)(32 * rg + r32) * 1024 + 32 * cg + 8 * q + 4 * hi) = o; }
    }
}
}
namespace att {
using bf16 = __hip_bfloat16;
constexpr int D = 128;
constexpr float THR = 8.f;
constexpr bool WSKIP = false;
constexpr float SCALE = 0.08838834764831845f;
constexpr int NW = 8, QBLK = 32, KVBLK = 64, QB = NW * QBLK;
constexpr int SHM_V = KVBLK * D * 2, SHM_K = KVBLK * D * 2;
constexpr int LDS_BYTES = 2 * SHM_V + 2 * SHM_K + NW * 64 * 4;
typedef short bf16x8 __attribute__((ext_vector_type(8)));
typedef short s16x4 __attribute__((ext_vector_type(4)));
typedef float f32x16 __attribute__((ext_vector_type(16)));
typedef float f32x4 __attribute__((ext_vector_type(4)));
typedef unsigned u32x4 __attribute__((ext_vector_type(4)));
template <class A, class Bt> struct same_t { static constexpr bool v = false; };
template <class A> struct same_t<A, A> { static constexpr bool v = true; };
#define KSWZ(row, colB) ((row) * 256 + ((colB) ^ (((row) & 7) << 4)))
#define SBAR() __builtin_amdgcn_sched_barrier(0)
__device__ __forceinline__ int v_st(int k, int c) { const int kk = (k & ~0xC) | ((k & 4) << 1) | ((k & 8) >> 1); return ((kk >> 3) * 4 + (c >> 5)) * 512 + ((kk & 7) * 32 + (c & 31)) * 2; }
__device__ __forceinline__ int v_rd_base(int lane) { return ((lane & 3) << 3) | (((lane >> 2) & 3) << 6) | (((lane >> 4) & 1) << 5) | (((lane >> 5) & 1) << 8); }
constexpr int v_rd_off(int d0, int ks, int half) { return d0 * 512 + ks * 4096 + half * 2048; }
__device__ __forceinline__ int crow(int r, int hi) { return (r & 3) + 8 * (r >> 2) + 4 * hi; }
__device__ __forceinline__ unsigned cvtpk(float lo, float hi) {
    unsigned r; asm volatile("v_cvt_pk_bf16_f32 %0, %1, %2" : "=v"(r) : "v"(lo), "v"(hi)); return r;
}
__device__ __forceinline__ bf16x8 pack8(f32x4 a, f32x4 b) {
    u32x4 w = {cvtpk(a[0], a[1]), cvtpk(a[2], a[3]), cvtpk(b[0], b[1]), cvtpk(b[2], b[3])};
    return *reinterpret_cast<bf16x8*>(&w);
}
template <class T> __device__ __forceinline__ bf16x8 load8(const T* p) {
    if constexpr (same_t<T, float>::v) { return pack8(*(const f32x4*)p, *(const f32x4*)(p + 4)); }
    else { return *reinterpret_cast<const bf16x8*>(p); }
}
__device__ __forceinline__ void mask_tile(f32x16& p0, f32x16& p1, int dq, unsigned W) {
    const float NEG = -__builtin_inff();
#pragma unroll
    for (int r = 0; r < 16; ++r) {
        const int c = (r & 3) + 8 * (r >> 2);
        if ((unsigned)(dq - c) >= W) p0[r] = NEG;
        if ((unsigned)(dq - c - 32) >= W) p1[r] = NEG;
    }
}
__device__ __forceinline__ void moba_mask_tile(f32x16& p0, f32x16& p1, int dq, const float* bt) {
    const float NEG = -__builtin_inff();
#pragma unroll
    for (int r = 0; r < 16; ++r) {
        const int c = (r & 3) + 8 * (r >> 2);
        const int d0 = dq - c, d1 = dq - c - 32;
        const float b0 = bt[d0 < 0 ? 0 : (d0 > 127 ? 127 : d0)], b1 = bt[d1 < 0 ? 0 : (d1 > 127 ? 127 : d1)];
        p0[r] = d0 < 0 ? NEG : p0[r] + b0;
        p1[r] = d1 < 0 ? NEG : p1[r] + b1;
        if ((r & 3) == 3) asm volatile("" ::: "memory");
    }
}
__device__ __forceinline__ void partialSM(f32x16& p0, f32x16& p1, float& m_reg, float& mn, float& alpha, float cadd = 0.f) {
    float pmax = p0[0]; for (int r = 1; r < 16; ++r) pmax = fmaxf(pmax, p0[r]); for (int r = 0; r < 16; ++r) pmax = fmaxf(pmax, p1[r]);
    { auto rr = __builtin_amdgcn_permlane32_swap(__float_as_uint(pmax), __float_as_uint(pmax), false, false);
      pmax = fmaxf(__uint_as_float(rr[0]), __uint_as_float(rr[1])); }
    pmax += cadd;
    constexpr float C2 = 1.4426950408889634f * SCALE;
    if (__builtin_expect(__all((pmax - m_reg) * SCALE <= THR), 1)) { mn = m_reg; alpha = 1.f; }
    else { mn = fmaxf(m_reg, pmax); alpha = __builtin_amdgcn_exp2f((m_reg - mn) * C2); m_reg = mn; }
    const float mnL = (cadd - mn) * C2;
    for (int r = 0; r < 16; ++r) p0[r] = fmaf(p0[r], C2, mnL); for (int r = 0; r < 16; ++r) p1[r] = fmaf(p1[r], C2, mnL);
    for (int r = 0; r < 16; ++r) p0[r] = __builtin_amdgcn_exp2f(p0[r]);
}
__device__ __forceinline__ void finishSM(f32x16& p0, f32x16& p1, float alpha, float& l_reg, bf16x8& pa0, bf16x8& pa1, bf16x8& pa2, bf16x8& pa3) {
    for (int r = 0; r < 16; ++r) p1[r] = __builtin_amdgcn_exp2f(p1[r]);
    float ps = 0; for (int r = 0; r < 16; ++r) ps += p0[r]; for (int r = 0; r < 16; ++r) ps += p1[r];
    { auto rr = __builtin_amdgcn_permlane32_swap(__float_as_uint(ps), __float_as_uint(ps), false, false);
      ps = __uint_as_float(rr[0]) + __uint_as_float(rr[1]); }
    l_reg = l_reg * alpha + ps;
#define PK4(P, B_, OUT) do { unsigned a0 = cvtpk(P[B_+0], P[B_+1]), a1 = cvtpk(P[B_+2], P[B_+3]);                          \
        unsigned b0 = cvtpk(P[B_+4], P[B_+5]), b1 = cvtpk(P[B_+6], P[B_+7]);                                             \
        auto r0 = __builtin_amdgcn_permlane32_swap(a0, b0, false, false); auto r1 = __builtin_amdgcn_permlane32_swap(a1, b1, false, false); \
        u32x4 w = {r0[0], r1[0], r0[1], r1[1]}; OUT = *reinterpret_cast<bf16x8*>(&w); } while (0)
    PK4(p0, 0, pa0); PK4(p0, 8, pa1); PK4(p1, 0, pa2); PK4(p1, 8, pa3);
#undef PK4
}
template <int KB, bool SK>
__device__ __forceinline__ void qkt(f32x16& p0, f32x16& p1, const char* K_lds, int r32, int hi, const bf16x8* qr, bool act) {
    if (SK && !act) { const float NEG = -__builtin_inff();
#pragma unroll
        for (int r = 0; r < 16; ++r) { p0[r] = NEG; p1[r] = NEG; } return; }
    p0 = f32x16{}; p1 = f32x16{};
    const char* kb[4];
#pragma unroll
    for (int dd = 0; dd < 4; ++dd) kb[dd] = K_lds + KB * SHM_K + KSWZ(r32, (dd * 16 + hi * 8) * 2);
#pragma unroll
    for (int d0 = 0; d0 < 8; ++d0) { const char* a = kb[d0 & 3] + (d0 >> 2) * 128;
        bf16x8 b0 = *reinterpret_cast<const bf16x8*>(a);
        bf16x8 b1 = *reinterpret_cast<const bf16x8*>(a + 32 * 256);
        p0 = __builtin_amdgcn_mfma_f32_32x32x16_bf16(b0, qr[d0], p0, 0, 0, 0);
        p1 = __builtin_amdgcn_mfma_f32_32x32x16_bf16(b1, qr[d0], p1, 0, 0, 0); }
}
template <int VB, bool SK>
__device__ __forceinline__ void pv_tile(f32x16* o, int vb0, bf16x8 pa0, bf16x8 pa1, bf16x8 pa2, bf16x8 pa3, bool act) {
    if (SK && !act) return;
#define TRRD(dst, off) asm volatile("ds_read_b64_tr_b16 %0, %1 offset:%2" : "=&v"(dst) : "v"(vb0), "i"(off) : "memory")
#define PV_D0(d0) do { s16x4 l0, l1, l2, l3, h0, h1, h2, h3; constexpr int b_ = VB * SHM_V + v_rd_off(d0, 0, 0);     \
        TRRD(l0, b_); TRRD(h0, b_ + 2048); TRRD(l1, b_ + 4096); TRRD(h1, b_ + 6144); TRRD(l2, b_ + 8192); TRRD(h2, b_ + 10240); TRRD(l3, b_ + 12288); TRRD(h3, b_ + 14336); \
        asm volatile("s_waitcnt lgkmcnt(0)" ::: "memory"); SBAR();                 \
        o[d0] = __builtin_amdgcn_mfma_f32_32x32x16_bf16(pa0, (bf16x8){l0[0], l0[1], l0[2], l0[3], h0[0], h0[1], h0[2], h0[3]}, o[d0], 0, 0, 0);   \
        o[d0] = __builtin_amdgcn_mfma_f32_32x32x16_bf16(pa1, (bf16x8){l1[0], l1[1], l1[2], l1[3], h1[0], h1[1], h1[2], h1[3]}, o[d0], 0, 0, 0);   \
        o[d0] = __builtin_amdgcn_mfma_f32_32x32x16_bf16(pa2, (bf16x8){l2[0], l2[1], l2[2], l2[3], h2[0], h2[1], h2[2], h2[3]}, o[d0], 0, 0, 0);   \
        o[d0] = __builtin_amdgcn_mfma_f32_32x32x16_bf16(pa3, (bf16x8){l3[0], l3[1], l3[2], l3[3], h3[0], h3[1], h3[2], h3[3]}, o[d0], 0, 0, 0); } while (0)
    PV_D0(0); PV_D0(1); PV_D0(2); PV_D0(3);
#undef PV_D0
#undef TRRD
}

__device__ __forceinline__ float cinit_moba(int kb, int cur_blk, unsigned selmask, int qlo, float b31) {
    const int n = kb >> 8;
    if (n != cur_blk && !((selmask >> n) & 1u)) return -__builtin_inff();
    return (kb + KVBLK - 1 + 113 > qlo) ? 0.f : b31;
}
template <class TIn, class TOut> struct BlockRef { const TIn* Q; const TIn* K; const TIn* V; TOut* O; int P0; const float* kp; const float* btg; int h; };
template <class TIn> struct Seam {
    bf16x8 qr[8];
    bf16x8 st_v0, st_v1, st_k0, st_k1; f32x4 sf0, sf1, sf2, sf3;
    f32x4 tq[16];
};
__device__ __forceinline__ int swa_jlo(int P0, int W) { const int lowk = P0 - W + 1; return lowk > 0 ? lowk / KVBLK : 0; }
#define ROW(p, k0, rr) ((p) + (size_t)(k0) * LDKV + (unsigned)((rr) * LDKV + sc))
#define VMW() asm volatile("s_waitcnt vmcnt(0)" ::: "memory")
#define VMWN(n) asm volatile("s_waitcnt vmcnt(%0)" :: "i"(n) : "memory")
#define SLOAD_H(Kp, Vp, k0) do { S.st_v0 = load8<TIn>(ROW(Vp, k0, sr)); S.st_v1 = load8<TIn>(ROW(Vp, k0, 32 + sr));              \
                         S.st_k0 = load8<TIn>(ROW(Kp, k0, sr)); S.st_k1 = load8<TIn>(ROW(Kp, k0, 32 + sr)); } while (0)
#define SWRITE_HK(bf) do { *(bf16x8*)(K_lds + (bf) * SHM_K + kws) = S.st_k0; *(bf16x8*)(K_lds + (bf) * SHM_K + kws + 32 * 256) = S.st_k1; } while (0)
#define SWRITE_HV(bf) do { *(bf16x8*)(V_lds + (bf) * SHM_V + vst0) = S.st_v0; *(bf16x8*)(V_lds + (bf) * SHM_V + vst1) = S.st_v1; } while (0)
#define SWRITE_H(bf) do { SWRITE_HV(bf); SWRITE_HK(bf); } while (0)
#define SLOAD_F(p, k0) do { S.sf0 = *(const f32x4*)ROW(p, k0, sr); S.sf1 = *(const f32x4*)(ROW(p, k0, sr) + 4);                \
                            S.sf2 = *(const f32x4*)ROW(p, k0, 32 + sr); S.sf3 = *(const f32x4*)(ROW(p, k0, 32 + sr) + 4); } while (0)
#define SWRITE_KF(bf) do { *(bf16x8*)(K_lds + (bf) * SHM_K + kws) = pack8(S.sf0, S.sf1); *(bf16x8*)(K_lds + (bf) * SHM_K + kws + 32 * 256) = pack8(S.sf2, S.sf3); } while (0)
#define SWRITE_VF(bf) do { *(bf16x8*)(V_lds + (bf) * SHM_V + vst0) = pack8(S.sf0, S.sf1); *(bf16x8*)(V_lds + (bf) * SHM_V + vst1) = pack8(S.sf2, S.sf3); } while (0)
template <class TIn, class TOut, int MODE, int LDQ, int LDKV>
__device__ __forceinline__ void causal_swa_prime(const BlockRef<TIn, TOut>& cur, int W, char* lds, Seam<TIn>& S, const int tid) {
    constexpr bool F32 = same_t<TIn, float>::v;
    const int wid = __builtin_amdgcn_readfirstlane(tid >> 6), lane = tid & 63, r32 = lane & 31, hi = lane >> 5;
    const int sr = tid >> 4, sc = (tid & 15) * 8, kws = KSWZ(sr, sc * 2); char* K_lds = lds + 2 * SHM_V;
    const int kb0 = swa_jlo(cur.P0, W) * KVBLK;
    for (int d0 = 0; d0 < 8; ++d0) S.qr[d0] = load8<TIn>(cur.Q + (unsigned)((wid * QBLK + r32) * LDQ + d0 * 16 + hi * 8));
    if constexpr (F32) { SLOAD_F((const float*)cur.K, kb0); VMW(); SWRITE_KF(0); SBAR(); SLOAD_F((const float*)cur.V, kb0); }
    else { SLOAD_H(cur.K, cur.V, kb0); VMW(); SWRITE_HK(0); }
    __syncthreads();
}
template <class TIn, class TOut, int MODE, int LDQ, int LDKV>
__device__ __forceinline__ void causal_swa_block(const BlockRef<TIn, TOut>& cur, const BlockRef<TIn, TOut>& nxt, int skv, int W, char* lds, Seam<TIn>& S, const int tid) {
    constexpr bool F32 = same_t<TIn, float>::v;
    const int wid = __builtin_amdgcn_readfirstlane(tid >> 6), lane = tid & 63, r32 = lane & 31, hi = lane >> 5;
    const int j_lo = swa_jlo(cur.P0, W);
    int j_hi = (cur.P0 + QB - 1) / KVBLK + 1; if (j_hi > skv / KVBLK) j_hi = skv / KVBLK;
    const int NT = j_hi - j_lo;
    const int kbn = swa_jlo(nxt.P0, W) * KVBLK;
    const int qlo = cur.P0 + wid * QBLK, qm = qlo + r32 - 4 * hi;
    char* V_lds = lds; char* K_lds = lds + 2 * SHM_V;
    float* ws = (float*)(lds + 2 * SHM_V + 2 * SHM_K) + wid * 64; float* li_l = ws, * al_l = ws + 32;
    float m_reg = -1e30f, l_reg = 0; f32x16 o[4] = {};
    const int sr = tid >> 4, sc = (tid & 15) * 8, vst0 = v_st(sr, sc), vst1 = v_st(32 + sr, sc), kws = KSWZ(sr, sc * 2);
    const int vb0 = (int)(uintptr_t)V_lds + v_rd_base(lane);
    const TIn* Kh = cur.K; const TIn* Vh = cur.V;
#define RESC(a) do { if (__any((a) < 1.f)) { if (hi == 0) al_l[r32] = (a); asm volatile("s_waitcnt lgkmcnt(0)" ::: "memory");              \
                     for (int d_ = 0; d_ < 4; ++d_) for (int r = 0; r < 16; ++r) o[d_][r] *= al_l[crow(r, hi)]; } } while (0)
#define KBASE(t) ((j_lo + (t)) * KVBLK)
#define ACT(t) (KBASE(t) <= qlo + QBLK - 1 && KBASE(t) + KVBLK - 1 >= qlo - W + 1)
#define MASKT(P0_, P1_, t) do { if constexpr (MODE == 1) { const int kb_ = KBASE(t); if (kb_ + KVBLK - 1 + 113 > qlo) moba_mask_tile(P0_, P1_, qm - kb_, btab); } \
        else if constexpr (MODE == 2) { const int kb_ = KBASE(t); if (kb_ + KVBLK - 1 > qlo) mask_tile(P0_, P1_, qm - kb_, (unsigned)W); } } while (0)
    constexpr int NQL = F32 ? 16 : 8;
    constexpr bool SK = WSKIP && !F32;
#define SEAM_K0() do { VMWN(NQL); if constexpr (F32) { SWRITE_KF(0); SBAR(); SLOAD_F((const float*)nxt.V, kbn); } else { SWRITE_HK(0); } SBAR(); } while (0)
    f32x16 pA0, pA1, pB0, pB1; float mnA, mnB, alA, alB; bf16x8 pa0, pa1, pa2, pa3;
    unsigned selmask = 0xFFFFFFFFu; float b31 = 0.f; const float* btab = nullptr; const int cur_blk = cur.P0 >> 8;
    if constexpr (MODE == 1) {
        float* kms = (float*)(lds + LDS_BYTES);
        float* btl = kms + 16 * 128;
        int tq = tid; asm volatile("" : "+v"(tq));
        const int hq = (tq >> 5) & 1;
        { const int n = tq >> 5, d4 = (tq & 31) * 4;
          if (n < cur_blk) { const float* k0 = cur.kp + ((size_t)n * 2) * 1024 + cur.h * 128 + d4; const f32x4 a = *(const f32x4*)k0, b = *(const f32x4*)(k0 + 1024); *(f32x4*)(kms + n * 128 + d4) = a + b; }
          if (tq < 128) btl[tq] = cur.btg[tq]; }
        __syncthreads();
        btab = btl; b31 = __builtin_bit_cast(float, __builtin_amdgcn_readfirstlane(__builtin_bit_cast(int, btl[127])));
        if (cur_blk <= 3) selmask = (1u << cur_blk) - 1u;
        else {
            float g[15];
#pragma unroll
            for (int n = 0; n < 15; ++n) { float s = -__builtin_inff();
                if (n < cur_blk) { s = 0.f;
#pragma unroll
                    for (int d0 = 0; d0 < 8; ++d0) { const bf16x8 q = S.qr[d0]; const float* kk = kms + n * 128 + d0 * 16 + hq * 8; const f32x4 k0 = *(const f32x4*)kk, k1 = *(const f32x4*)(kk + 4);
#pragma unroll
                        for (int j = 0; j < 4; ++j) { s = fmaf(__builtin_bit_cast(float, (unsigned)(unsigned short)q[j] << 16), k0[j], s); s = fmaf(__builtin_bit_cast(float, (unsigned)(unsigned short)q[4 + j] << 16), k1[j], s); } }
                    s += __shfl_xor(s, 32); }
                g[n] = s; }
            selmask = 0u;
#pragma unroll
            for (int r = 0; r < 3; ++r) { float bv = -__builtin_inff(); int bi = 0;
#pragma unroll
                for (int n = 0; n < 15; ++n) { const bool take = !((selmask >> n) & 1u) && g[n] > bv; bv = take ? g[n] : bv; bi = take ? n : bi; }
                selmask |= 1u << bi; }
        }
    }
#define CINIT(t) (MODE == 1 ? cinit_moba(KBASE(t), cur_blk, selmask, qlo, b31) : 0.f)
    if constexpr (F32) { VMW(); SWRITE_VF(0); SBAR(); } else { SWRITE_HV(0); SBAR(); }
    if (NT > 1) { if constexpr (F32) SLOAD_F((const float*)Kh, KBASE(1)); else SLOAD_H(Kh, Vh, KBASE(1)); }
    SBAR(); qkt<0, SK>(pA0, pA1, K_lds, r32, hi, S.qr, ACT(0));
    if constexpr (F32) { if (NT > 1) { VMW(); SWRITE_KF(1); SBAR(); SLOAD_F((const float*)Vh, KBASE(1)); } }
    MASKT(pA0, pA1, 0); partialSM(pA0, pA1, m_reg, mnA, alA, CINIT(0));
    if (NT > 1) { VMW(); if constexpr (F32) { SWRITE_VF(1); SBAR(); if (NT > 2) SLOAD_F((const float*)Kh, KBASE(2)); } else SWRITE_H(1); }
    __syncthreads();
#define HALF_STEP(PX0, PX1, mnX, alX, PY0, PY1, alY, t, KB, VB, SB) do {                                                      \
        SBAR(); qkt<KB, SK>(PX0, PX1, K_lds, r32, hi, S.qr, ACT(t));                                             \
        finishSM(PY0, PY1, alY, l_reg, pa0, pa1, pa2, pa3); SBAR();                                                           \
        if ((t) + 1 < NT) { if constexpr (F32) { VMW(); SWRITE_KF(SB); SBAR(); SLOAD_F((const float*)Vh, KBASE((t) + 1)); }  \
                            else { SLOAD_H(Kh, Vh, KBASE((t) + 1)); } SBAR(); }                                               \
        pv_tile<VB, SK>(o, vb0, pa0, pa1, pa2, pa3, ACT((t) - 1)); MASKT(PX0, PX1, (t)); partialSM(PX0, PX1, m_reg, mnX, alX, CINIT(t));                                        \
        __syncthreads();                                                                                                      \
        if ((t) + 1 < NT) { VMW(); if constexpr (F32) { SWRITE_VF(SB); SBAR(); if ((t) + 2 < NT) SLOAD_F((const float*)Kh, KBASE((t) + 2)); } \
                            else { SWRITE_H(SB); } }                                                                          \
        RESC(alX); __syncthreads(); } while (0)
    for (int t = 1; t + 1 < NT; t += 2) {
        HALF_STEP(pB0, pB1, mnB, alB, pA0, pA1, alA, t, 1, 0, 0);
        HALF_STEP(pA0, pA1, mnA, alA, pB0, pB1, alB, t + 1, 0, 1, 1);
    }
    const bool even = (NT & 1) == 0;
    if (even) { SBAR(); qkt<1, SK>(pB0, pB1, K_lds, r32, hi, S.qr, ACT(NT - 1)); SBAR(); }
#define QROW(e) (nxt.Q + (size_t)(wid * QBLK + r32) * LDQ + ((e) >> 1) * 16 + hi * 8 + ((e) & 1) * 4)
    if constexpr (F32) { SLOAD_F((const float*)nxt.K, kbn); SBAR();
#pragma unroll
        for (int e = 0; e < 8; ++e) S.tq[e] = *(const f32x4*)QROW(e); }
    else { SLOAD_H(nxt.K, nxt.V, kbn); SBAR();
#pragma unroll
        for (int d0 = 0; d0 < 8; ++d0) S.qr[d0] = load8<TIn>(nxt.Q + (unsigned)((wid * QBLK + r32) * LDQ + d0 * 16 + hi * 8)); }
    SBAR();
    finishSM(pA0, pA1, alA, l_reg, pa0, pa1, pa2, pa3); SBAR();
    if constexpr (F32) {
#pragma unroll
        for (int e = 8; e < 16; ++e) S.tq[e] = *(const f32x4*)QROW(e); SBAR(); }
#undef QROW
    pv_tile<0, SK>(o, vb0, pa0, pa1, pa2, pa3, ACT(even ? NT - 2 : NT - 1));
    if (even) { MASKT(pB0, pB1, NT - 1); partialSM(pB0, pB1, m_reg, mnB, alB, CINIT(NT - 1)); __syncthreads(); RESC(alB);
        finishSM(pB0, pB1, alB, l_reg, pa0, pa1, pa2, pa3); SBAR(); pv_tile<1, SK>(o, vb0, pa0, pa1, pa2, pa3, ACT(NT - 1)); }
    SBAR(); SEAM_K0();
    if (hi == 0) li_l[r32] = l_reg; asm volatile("s_waitcnt lgkmcnt(0)" ::: "memory");
    float rli[16];
#pragma unroll
    for (int r = 0; r < 16; ++r) rli[r] = __builtin_amdgcn_rcpf(li_l[crow(r, hi)]);
    TOut* Ow = cur.O;
#pragma unroll
    for (int r = 0; r < 16; ++r) { const int orow = crow(r, hi);
#pragma unroll
        for (int d0 = 0; d0 < 4; ++d0) { const float v = o[d0][r] * rli[r];
            if constexpr (same_t<TOut, float>::v) { Ow[(unsigned)((wid * QBLK + orow) * LDQ + d0 * 32 + r32)] = v; }
            else { const float vn = __shfl_xor(v, 1);
                   if ((r32 & 1) == 0) *(unsigned*)(Ow + (unsigned)((wid * QBLK + orow) * LDQ + d0 * 32 + r32)) = cvtpk(v, vn); } } }
    if constexpr (F32) {
#pragma unroll
        for (int d0 = 0; d0 < 8; ++d0) S.qr[d0] = pack8(S.tq[2 * d0], S.tq[2 * d0 + 1]); }
    __syncthreads();
#undef RESC
#undef KBASE
#undef ACT
#undef MASKT
#undef CINIT
#undef SEAM_K0
#undef HALF_STEP
}
#undef ROW
#undef VMW
#undef VMWN
#undef SLOAD_H
#undef SWRITE_HK
#undef SWRITE_HV
#undef SWRITE_H
#undef SLOAD_F
#undef SWRITE_KF
#undef SWRITE_VF
}
namespace mk {
typedef att::BlockRef<att::bf16, att::bf16> ARef;

__device__ __forceinline__ ARef moba_ref(PPtr p, int L, int pass, att::bf16* oalt = nullptr) {
    const int xcd = L & 7, kk = L >> 3, bh = xcd + 8 * (kk >> 3), pr = kk & 7, b = bh >> 3, h = bh & 7;
    const int qb = pass ? 15 - pr : pr;
    ARef r;
    att::bf16* Q = (att::bf16*)(p->ws + WS_Q); const att::bf16* K = (const att::bf16*)(p->ws + WS_K); const att::bf16* V = (const att::bf16*)(p->ws + WS_V);
    r.Q = Q + ((size_t)b * S + (size_t)qb * 256) * 1024 + h * 128; r.O = Q + ((size_t)b * S + (size_t)qb * 256) * 1024 + h * 128;
    r.K = K + (size_t)b * S * 1024 + h * 128; r.V = V + (size_t)b * S * 1024 + h * 128; r.P0 = qb * 256;
    if (oalt) r.O = oalt + ((size_t)b * S + (size_t)qb * 256) * 1024 + h * 128;
    r.kp = (const float*)(p->ws + WS_KPART) + (size_t)b * 16 * 2 * 1024; r.btg = (const float*)(p->ws + WS_BTAB) + h * 128; r.h = h;
    return r;
}
template <int MODE = 1> __device__ __forceinline__ void phase_moba(PPtr p, char* lds, int G, const int tid, att::bf16* oalt = nullptr) {
    constexpr int total = 512;
    int L = blockIdx.x; if (L >= total) return;
    int pass = 0;
    ARef cur = moba_ref(p, L, 0, oalt);
    att::Seam<att::bf16> Sm;
    att::causal_swa_prime<att::bf16, att::bf16, MODE, 1024, 1024>(cur, 1 << 30, lds, Sm, tid);
    for (;;) {
        const bool more_pass = pass == 0, more_item = L + G < total, last = !more_pass && !more_item;
        int passn = pass + 1, Ln = L;
        if (!more_pass) { passn = 0; Ln = more_item ? L + G : L; }
        const ARef nxt = last ? cur : moba_ref(p, Ln, passn, oalt);
        att::causal_swa_block<att::bf16, att::bf16, MODE, 1024, 1024>(cur, nxt, S, 1 << 30, lds, Sm, tid);
        if (last) break;
        cur = nxt; pass = passn; L = Ln;
    }
}
__device__ __forceinline__ bool xattn_ref(PPtr p, int k, int G, ARef& r, att::bf16* oalt) {
    const int L = (k >> 1) * G + (int)blockIdx.x; if (L >= 128 * 2) return false;
    int pm, pn; tile_order(L, 128, 2, pm, pn);
    const int b = pm >> 4, qb = pm & 15, xh = 2 * pn + (k & 1);
    att::bf16* Q = (att::bf16*)(p->ws + WS_Q2); const att::bf16* KV = (const att::bf16*)(p->ws + WS_KVM);
    r.Q = Q + ((size_t)b * S + (size_t)qb * 256) * XW + xh * 128; r.O = Q + ((size_t)b * S + (size_t)qb * 256) * XW + xh * 128;
    r.K = KV + (size_t)b * MEM * 1024 + xh * 128; r.V = KV + (size_t)b * MEM * 1024 + 512 + xh * 128; r.P0 = 256;
    if (oalt) r.O = oalt + ((size_t)b * S + (size_t)qb * 256) * XW + xh * 128;
    r.kp = nullptr; r.btg = nullptr; r.h = 0;
    return true;
}
__device__ __forceinline__ void phase_xattn(PPtr p, char* lds, int G, const int tid, att::bf16* oalt) {
    ARef cur, nxt;
    if (!xattn_ref(p, 0, G, cur, oalt)) return;
    att::Seam<att::bf16> Sm;
    att::causal_swa_prime<att::bf16, att::bf16, 0, 512, 1024>(cur, 1 << 30, lds, Sm, tid);
    for (int k = 0;; ++k) {
        const bool last = !xattn_ref(p, k + 1, G, nxt, oalt);
        if (last) nxt = cur;
        att::causal_swa_block<att::bf16, att::bf16, 0, 512, 1024>(cur, nxt, MEM, 1 << 30, lds, Sm, tid);
        if (last) break;
        cur = nxt;
    }
}

template <int VAR = 0> __device__ __forceinline__ void phase_sgu(PPtr p, LAS unsigned char* lds, int G, const int tid) {
    typedef short s16x4 __attribute__((ext_vector_type(4)));
    const int lane = tid & 63, wave = __builtin_amdgcn_readfirstlane(tid >> 6);
    bf16* U = (bf16*)(p->ws + WS_U); const bf16* GV = (const bf16*)(p->ws + WS_GV); const float* vstat = (const float*)(p->ws + WS_VSTAT);
    const bf16* WSP = (const bf16*)(p->ws + WS_WSP);
    constexpr int RS = 40;
    constexpr int NUNITS = (T / 128) * 8;
    LAS unsigned char* img = lds + wave * 5120;
    LAS float* rtab = (LAS float*)(lds + 8 * 5120);
    const int fr = lane & 15, kg = lane >> 4;
    const int bx = blockIdx.x;
    { const int nun = (NUNITS - bx + G - 1) / G;
_Pragma("unroll 2")
      for (int e = tid; e < nun * 128; e += NTHREADS) { const int j = e >> 7, unit = bx + j * G; rtab[e] = row_rstd(vstat, (size_t)((unit >> 3) * 128 + (e & 127))); } }
    __syncthreads();
    bf16x8 wf[20]; int g_have = -1;
    v2u uuA[8], uuB[8]; v4u gvA[4], gvB[4];
#define SGU_LOAD(unit_, uu_, gv_) do { const int g_ = (unit_) & 7, t0_ = ((unit_) >> 3) * 128; \
        _Pragma("unroll") for (int i = 0; i < 8; ++i) { if (VAR == 3) uu_[i] = (v2u){(unsigned)t0_, (unsigned)i}; else if (VAR == 5) uu_[i] = *(const v2u*)(U + ((size_t)(unit_) * 8 + wave) * 2048 + (size_t)(i * 64 + lane) * 4); else uu_[i] = *(const v2u*)(U + (size_t)(t0_ + 16 * i + fr) * 1024 + g_ * 128 + 16 * wave + 4 * kg); } \
        _Pragma("unroll") for (int i = 0; i < 4; ++i) { if (VAR == 2) gv_[i] = (v4u){(unsigned)t0_, (unsigned)i, 1u, 2u}; else if (VAR == 5) gv_[i] = *(const v4u*)(GV + ((size_t)(unit_) * 8 + wave) * 2048 + (size_t)(i * 64 + lane) * 8); else gv_[i] = *(const v4u*)(GV + (size_t)(t0_ + (lane >> 1) + 32 * i) * 1024 + g_ * 128 + 16 * wave + (lane & 1) * 8); } } while (0)
#define SGU_UNIT(unit_, j_, uu_, gv_) do { const int g = (unit_) & 7, t0 = ((unit_) >> 3) * 128; \
        if (g != g_have) { const bf16* wg = WSP + (size_t)g * 128 * 128; int n_ = 0;     \
            _Pragma("unroll") for (int i = 0; i < 8; ++i) _Pragma("unroll") for (int ks = 0; ks < 4; ++ks) if (ks < (16 * i + 15) / 32 + 1) { wf[n_] = *(const bf16x8*)(wg + (size_t)(16 * i + fr) * 128 + 32 * ks + 8 * kg); ++n_; } \
            g_have = g; } \
        float bbv[8]; _Pragma("unroll") for (int i = 0; i < 8; ++i) bbv[i] = p->b_spatial[g * 128 + 16 * i + fr];     \
        const f32x4 n0 = *(const f32x4*)(p->sgu_norm + g * 128 + 16 * wave + (lane & 1) * 8), n1 = *(const f32x4*)(p->sgu_norm + g * 128 + 16 * wave + (lane & 1) * 8 + 4); \
        if (VAR != 4 && VAR != 5) { _Pragma("unroll") for (int i = 0; i < 4; ++i) { const int s_ = (lane >> 1) + 32 * i; const float rs = rtab[(j_) * 128 + s_]; const v4u w = gv_[i]; \
            v4u o; o.x = pk2(bflo(w.x) * rs * n0[0], bfhi(w.x) * rs * n0[1]); o.y = pk2(bflo(w.y) * rs * n0[2], bfhi(w.y) * rs * n0[3]); \
            o.z = pk2(bflo(w.z) * rs * n1[0], bfhi(w.z) * rs * n1[1]); o.w = pk2(bflo(w.w) * rs * n1[2], bfhi(w.w) * rs * n1[3]); \
            LAS unsigned char* d = img + s_ * RS + (lane & 1) * 16; *(LAS v2u*)d = (v2u){o.x, o.y}; *(LAS v2u*)(d + 8) = (v2u){o.z, o.w}; } } \
        asm volatile("s_waitcnt lgkmcnt(0)" ::: "memory"); \
        bf16x8 af[4];     \
        if (VAR == 4 || VAR == 5) { _Pragma("unroll") for (int ks = 0; ks < 4; ++ks) af[ks] = (bf16x8){(short)gv_[ks].x, 0, 0, 0, 0, 0, 0, 0}; } else \
        { const int q = (lane & 15) >> 2, pp = lane & 3; const LAS unsigned char* base = img + (8 * kg + q) * RS + pp * 8; \
          _Pragma("unroll") for (int ks = 0; ks < 4; ++ks) { s16x4 lo, hi; \
              asm volatile("ds_read_b64_tr_b16 %0, %1" : "=v"(lo) : "v"(base + (32 * ks) * RS) : "memory"); \
              asm volatile("ds_read_b64_tr_b16 %0, %1" : "=v"(hi) : "v"(base + (32 * ks + 4) * RS) : "memory"); \
              asm volatile("s_waitcnt lgkmcnt(0)" : "+v"(lo), "+v"(hi) :: "memory"); \
              af[ks] = (bf16x8){lo[0], lo[1], lo[2], lo[3], hi[0], hi[1], hi[2], hi[3]}; } } \
        __builtin_amdgcn_sched_barrier(0); \
        int n = 0; \
        _Pragma("unroll") for (int i = 0; i < 8; ++i) { f32x4 acc = {0.f, 0.f, 0.f, 0.f}; \
            if (VAR == 4 || VAR == 5) { acc[0] = __builtin_bit_cast(float, (int)af[i & 3][0]); } else { _Pragma("unroll") for (int ks = 0; ks < 4; ++ks) if (ks < (16 * i + 15) / 32 + 1) { acc = __builtin_amdgcn_mfma_f32_16x16x32_bf16(af[ks], wf[n], acc, 0, 0, 0); ++n; } } \
            const float bb = bbv[i];     \
            v2u r; r.x = pk2(gelu_tanh(bflo(uu_[i].x)) * (acc[0] + bb), gelu_tanh(bfhi(uu_[i].x)) * (acc[1] + bb)); r.y = pk2(gelu_tanh(bflo(uu_[i].y)) * (acc[2] + bb), gelu_tanh(bfhi(uu_[i].y)) * (acc[3] + bb));     \
            if (VAR == 5) *(v2u*)(U + ((size_t)(unit_) * 8 + wave) * 2048 + (size_t)(i * 64 + lane) * 4) = r; else if (VAR != 1 || r.x == 0x12345678u) *(v2u*)(U + (size_t)(t0 + 16 * i + fr) * 1024 + g * 128 + 16 * wave + 4 * kg) = r; } } while (0)
    if (bx < NUNITS) {
        SGU_LOAD(bx, uuA, gvA);
        int j = 0;
        for (int unit = bx; unit < NUNITS; unit += 2 * G, j += 2) {
            const bool hb = unit + G < NUNITS;
            if (hb) SGU_LOAD(unit + G, uuB, gvB);
            SGU_UNIT(unit, j, uuA, gvA);
            if (!hb) break;
            const bool ha = unit + 2 * G < NUNITS;
            if (ha) SGU_LOAD(unit + 2 * G, uuA, gvA);
            SGU_UNIT(unit + G, j + 1, uuB, gvB);
            if (!ha) break;
        }
    }
#undef SGU_LOAD
#undef SGU_UNIT
    __syncthreads();
}
}
namespace mk {
__device__ __forceinline__ void build_tiles(PPtr p, LAS unsigned char* lds, const int tid) {
    LAS int* tb = (LAS int*)(lds + LDS_MISC);
    const int* counts = (const int*)(p->ws + WS_CTL);
    if (tid == 0) {
        int tl = 0;
        for (int e = 0; e < NE; ++e) { tb[e] = tl * 256; const int nt = (__hip_atomic_load(counts + e, __ATOMIC_RELAXED, __HIP_MEMORY_SCOPE_AGENT) + 255) >> 8; for (int i = 0; i < nt; ++i) tb[128 + tl + i] = e; tl += nt; }
        tb[64] = tl;
    }
    __syncthreads();
}
template <class FP> __device__ __forceinline__ void route_token(FP rl, const float* __restrict__ b_rg, const float* __restrict__ b_re, int t, int* __restrict__ eid, float* __restrict__ wt, LAS int* hist) {
    float g[8]; float gm = -3.0e38f; int gs = 0;
#pragma unroll
    for (int i = 0; i < 8; ++i) { g[i] = rl[i] + b_rg[i]; if (g[i] > gm) { gm = g[i]; gs = i; } }
    float gsum = 0.f;
#pragma unroll
    for (int i = 0; i < 8; ++i) gsum += __expf(g[i] - gm);
    const float pg = 1.0f / gsum;
    float e[8]; float em = -3.0e38f;
#pragma unroll
    for (int i = 0; i < 8; ++i) { e[i] = rl[8 + gs * 8 + i] + b_re[gs * 8 + i]; em = fmaxf(em, e[i]); }
    float esum = 0.f; float pe[8];
#pragma unroll
    for (int i = 0; i < 8; ++i) { pe[i] = __expf(e[i] - em); esum += pe[i]; }
#pragma unroll
    for (int i = 0; i < 8; ++i) pe[i] /= esum;
    int i0 = 0; float p0 = pe[0];
#pragma unroll
    for (int i = 1; i < 8; ++i) if (pe[i] > p0) { p0 = pe[i]; i0 = i; }
    int i1 = -1; float p1 = -1.0f;
#pragma unroll
    for (int i = 0; i < 8; ++i) if (i != i0 && pe[i] > p1) { p1 = pe[i]; i1 = i; }
    const float ps = p0 + p1;
    const int e0 = gs * 8 + i0, e1 = gs * 8 + i1;
    eid[2 * t] = e0; eid[2 * t + 1] = e1; wt[2 * t] = pg * (p0 / ps); wt[2 * t + 1] = pg * (p1 / ps);
    __hip_atomic_fetch_add(hist + e0, 1, __ATOMIC_RELAXED, __HIP_MEMORY_SCOPE_WORKGROUP); __hip_atomic_fetch_add(hist + e1, 1, __ATOMIC_RELAXED, __HIP_MEMORY_SCOPE_WORKGROUP);
}
__device__ __forceinline__ void init_slots(PPtr p, int vcu, int G, const int tid) {
    const int gt = vcu * NTHREADS + tid, NGT = G * NTHREADS;
    int* slotp = (int*)(p->ws + WS_SLOTP); unsigned* slotoff = (unsigned*)(p->ws + WS_SLOTOFF);
    for (int i = gt; i < MAXSLOTS; i += NGT) { slotp[i] = -1; slotoff[i] = 0u; }
}
struct EpiRouteFused {
    static constexpr bool PERM = true, AFTER_DRAIN = true, CHAIN = false;
    const float* stat; const float* b_rg; const float* b_re; int* eid; float* wt; int* counts;
    __device__ __forceinline__ void fused(f32x4 (&acc)[2][2][4][2], const Unit& u, int wr, int wc, int fr, int fq, LAS unsigned char* lds, int wid, int lane) const {
        LAS float* L = (LAS float*)lds;
        LAS int* hist = (LAS int*)(lds + 256 * 73 * 4);
        const int tid = wid * 64 + lane;
        if (tid < NE) hist[tid] = 0;
        const int row0 = u.pm * 256 + wr * 64 + fr;
        float rsv[8];
#pragma unroll
        for (int k = 0; k < 8; ++k) rsv[k] = row_rstd(stat, (size_t)EPI_ROWS(k >> 2, k & 3));
#pragma unroll
        for (int ai = 0; ai < 2; ++ai)
#pragma unroll
            for (int m = 0; m < 4; ++m) { const int rl = ai * 128 + wr * 64 + m * 16 + fr; const float rs = rsv[ai * 4 + m];
#pragma unroll
                for (int n = 0; n < 2; ++n)
#pragma unroll
                    for (int j = 0; j < 4; ++j) { const int col = 32 * wc + 8 * fq + 4 * n + j; if (col < 72) L[rl * 73 + col] = acc[ai][0][m][n][j] * rs; } }
        __syncthreads();
        if (tid < 256) route_token(L + tid * 73, b_rg, b_re, u.pm * 256 + tid, eid, wt, hist);
        __syncthreads();
        if (tid < NE) { const int c = hist[tid]; if (c) atomicAdd(counts + tid, c); }
    }
};
__device__ __forceinline__ void phase_dispatch(PPtr p, LAS unsigned char* lds, int vcu, int G, const int tid) {
    build_tiles(p, lds, tid);
    const LAS int* tb = (const LAS int*)(lds + LDS_MISC);
    const int gt = vcu * NTHREADS + tid, NGT = G * NTHREADS;
    const int* eid = (const int*)(p->ws + WS_EID); int* cursor = (int*)(p->ws + WS_CTL) + 64;
    int* slotp = (int*)(p->ws + WS_SLOTP); float* slotrs = (float*)(p->ws + WS_SLOTRS); unsigned* slotoff = (unsigned*)(p->ws + WS_SLOTOFF);
    const float* st2 = (const float*)(p->ws + WS_ST2);
    for (int pr = gt; pr < 2 * T; pr += NGT) {
        const int e = eid[pr], tok = pr >> 1;
        const int slot = tb[e] + atomicAdd(cursor + e, 1);
        slotp[slot] = pr; slotoff[slot] = (unsigned)tok * 1024u; slotrs[slot] = row_rstd(st2, (size_t)tok);
    }
}
constexpr int NPRE = 5, TABA_OFF = LDS_MISC + 2048, TABB_OFF = LDS_MISC + 8448;
struct SchedExpert {
    const char* A; const char* B; size_t a_tstep, b_estep, b_tstep; const LAS int* tb; int G, c; const unsigned* slotoff; int nt;
    const LAS unsigned* taba;
    __device__ __forceinline__ bool next(int i, Unit& u) const {
        const int L = i * G + c; if (L >= nt * 4) return false;
        int w = L; { const int nwg = nt * 4, q = nwg / 8, r = nwg % 8, xcd = w % 8, off = w / 8; w = (xcd < r ? xcd * (q + 1) : r * (q + 1) + (xcd - r) * q) + off; }
        const int ti = w >> 2, pn = w & 3, e = __builtin_amdgcn_readfirstlane(tb[128 + ti]);
        u.pm = ti; u.pn = pn; u.A = A + (size_t)ti * a_tstep; u.B = B + (size_t)e * b_estep + (size_t)pn * b_tstep; u.aux = e; u.ord = i; return true; }
    __device__ __forceinline__ const unsigned* rowtab(const Unit& u) const { return slotoff + (size_t)u.pm * 256; }
    __device__ __forceinline__ const LAS unsigned* rowtab_lds(const Unit& u) const { return (taba && u.ord < NPRE) ? taba + u.ord * 256 : nullptr; }
    __device__ __forceinline__ void a_ready(const Unit&) const {}
    __device__ __forceinline__ void done(const Unit&) const {}
};
__device__ __forceinline__ void preload_unit_tables(const SchedExpert& S, LAS unsigned char* lds, const int tid, const unsigned* srcA, const unsigned* srcB) {
    LAS unsigned* ta = (LAS unsigned*)(lds + TABA_OFF); LAS unsigned* tbb = (LAS unsigned*)(lds + TABB_OFF);
    if (tid < 256) {
        unsigned a[NPRE], b[NPRE]; int pm[NPRE];
#pragma unroll
        for (int i = 0; i < NPRE; ++i) { Unit u; pm[i] = S.next(i, u) ? u.pm : -1; }
#pragma unroll
        for (int i = 0; i < NPRE; ++i) { const size_t o = (size_t)(pm[i] < 0 ? 0 : pm[i]) * 256 + tid; a[i] = srcA[o]; b[i] = srcB ? srcB[o] : 0u; }
#pragma unroll
        for (int i = 0; i < NPRE; ++i) { ta[i * 256 + tid] = a[i]; if (srcB) tbb[i * 256 + tid] = b[i]; }
    }
    __syncthreads();
}
struct EpiG7 {
    static constexpr bool PERM = true, AFTER_DRAIN = false, CHAIN = false;
    unsigned char* HDN; const float* slotrs; const LAS float* tabb;
    __device__ __forceinline__ void operator()(AccRef acc, const Unit& u, int wr, int wc, int fr, int fq) const {
        const int row0 = u.pm * 256 + wr * 64 + fr, c0 = u.pn * 128 + wc * 32 + 8 * fq;
        float lim = 448.f; asm volatile("" : "+s"(lim));
        float rsv[8];
#pragma unroll
        for (int k = 0; k < 8; ++k) rsv[k] = (u.ord < NPRE ? tabb[u.ord * 256 + wr * 64 + fr + (k >> 2) * 128 + (k & 3) * 16] : slotrs[EPI_ROWS(k >> 2, k & 3)]) * (1.0f / WGU_SCALE);
#pragma unroll
        for (int ai = 0; ai < 2; ++ai)
#pragma unroll
            for (int m = 0; m < 4; ++m) { const size_t r = (size_t)EPI_ROWS(ai, m); const float rs = rsv[ai * 4 + m];
                f32x4 a = acc[ai][0][m][0] * rs, b = acc[ai][0][m][1] * rs; const f32x4 ua = acc[ai][1][m][0] * (rs * HDN_SCALE), ub = acc[ai][1][m][1] * (rs * HDN_SCALE);
#pragma unroll
                for (int j = 0; j < 4; ++j) { a[j] = fminf(fmaxf(a[j] * sigmoid_f(a[j]) * ua[j], -lim), lim); b[j] = fminf(fmaxf(b[j] * sigmoid_f(b[j]) * ub[j], -lim), lim); }
                v2u w8; w8.x = pk4_fp8(a[0], a[1], a[2], a[3]); w8.y = pk4_fp8(b[0], b[1], b[2], b[3]);
                *(v2u*)(HDN + r * EH + c0) = w8; }
    }
};
struct EpiG8 {
    static constexpr bool PERM = true, AFTER_DRAIN = false, CHAIN = false;
    unsigned char* Y; const int* slotp; const LAS int* taba;
    __device__ __forceinline__ void operator()(AccRef acc, const Unit& u, int wr, int wc, int fr, int fq) const {
        const int row0 = u.pm * 256 + wr * 64 + fr, c0 = u.pn * 256 + wc * 32 + 8 * fq;
        constexpr float sc = Y_SCALE / (HDN_SCALE * WD_SCALE);
        int prv[8];
#pragma unroll
        for (int k = 0; k < 8; ++k) prv[k] = u.ord < NPRE ? taba[u.ord * 256 + wr * 64 + fr + (k >> 2) * 128 + (k & 3) * 16] : slotp[EPI_ROWS(k >> 2, k & 3)];
#pragma unroll
        for (int ai = 0; ai < 2; ++ai)
#pragma unroll
            for (int m = 0; m < 4; ++m) { const int pr = prv[ai * 4 + m];
                if (pr >= 0) {
#pragma unroll
                    for (int bj = 0; bj < 2; ++bj) { const f32x4 a = acc[ai][bj][m][0] * sc, b = acc[ai][bj][m][1] * sc; v2u w8; w8.x = pk4_fp8(a[0], a[1], a[2], a[3]); w8.y = pk4_fp8(b[0], b[1], b[2], b[3]);
                        *(v2u*)(Y + ((unsigned)pr * 1024u + (unsigned)(c0 + bj * 128))) = w8; } } }
    }
};
__device__ __forceinline__ void phase_final(PPtr p, int vcu, int G, const int tid, float* oalt) {
    const int lane = tid & 63, wave = tid >> 6; const int gw = vcu * NWAVES + wave, NGW = G * NWAVES;
    const unsigned char* Y = p->ws + WS_Y; const float* wt = (const float*)(p->ws + WS_WT); const bf16* HB = (const bf16*)(p->ws + WS_HB);
    float* outp = oalt ? oalt : p->out;
    f32x4 gg[2][2];
#pragma unroll
    for (int j = 0; j < 2; ++j) { gg[j][0] = *(const f32x4*)(p->norm_final + (lane + 64 * j) * 8); gg[j][1] = *(const f32x4*)(p->norm_final + (lane + 64 * j) * 8 + 4); }
    for (int t = gw; t < T; t += NGW) {
        const float w0 = wt[2 * t] * (1.0f / Y_SCALE), w1 = wt[2 * t + 1] * (1.0f / Y_SCALE);
        const v4u* hr = (const v4u*)(HB + (size_t)t * 1024) + lane;
        const v2u* y0 = (const v2u*)(Y + (size_t)(2 * t) * 1024) + lane; const v2u* y1 = (const v2u*)(Y + (size_t)(2 * t + 1) * 1024) + lane;
        v4u hv[2]; v2u av[2], bv[2];
#pragma unroll
        for (int j = 0; j < 2; ++j) { hv[j] = hr[64 * j]; av[j] = y0[64 * j]; bv[j] = y1[64 * j]; }
        f32x4 v[2][2]; float s = 0.f;
#pragma unroll
        for (int j = 0; j < 2; ++j) { const v4u h = hv[j]; const f32x4 a0 = unpk4_fp8(av[j].x), a1 = unpk4_fp8(av[j].y), b0 = unpk4_fp8(bv[j].x), b1 = unpk4_fp8(bv[j].y);
            v[j][0] = (f32x4){bflo(h.x) + (w0 * a0[0] + w1 * b0[0]), bfhi(h.x) + (w0 * a0[1] + w1 * b0[1]), bflo(h.y) + (w0 * a0[2] + w1 * b0[2]), bfhi(h.y) + (w0 * a0[3] + w1 * b0[3])};
            v[j][1] = (f32x4){bflo(h.z) + (w0 * a1[0] + w1 * b1[0]), bfhi(h.z) + (w0 * a1[1] + w1 * b1[1]), bflo(h.w) + (w0 * a1[2] + w1 * b1[2]), bfhi(h.w) + (w0 * a1[3] + w1 * b1[3])};
#pragma unroll
            for (int q = 0; q < 2; ++q) s += (v[j][q][0] * v[j][q][0] + v[j][q][1] * v[j][q][1]) + (v[j][q][2] * v[j][q][2] + v[j][q][3] * v[j][q][3]); }
        const float rstd = rsqrtf(wave_sum(s) * (1.f / 1024.f) + EPS);
        f32x4* orow = (f32x4*)(outp + (size_t)t * 1024);
#pragma unroll
        for (int j = 0; j < 2; ++j) { __builtin_nontemporal_store(v[j][0] * rstd * gg[j][0], orow + (lane + 64 * j) * 2); __builtin_nontemporal_store(v[j][1] * rstd * gg[j][1], orow + (lane + 64 * j) * 2 + 1); }
    }
}
}
#define XB_TMO      128
#define XB_XCNT(j)  (256  + 64 * (j))
#define XB_XSUB(j)  (1280 + 64 * (j))
#define XB_XGEN(j)  (2304 + 64 * (j))
#define XB_TOP      3328
#define XB_TOPGEN   3392
#define XCD_BAR_WORDS 3456
#define XB_SPIN_CAP (1u << 23)

__device__ __forceinline__ unsigned xb_ld(unsigned* p)              { return __hip_atomic_load(p, __ATOMIC_RELAXED, __HIP_MEMORY_SCOPE_AGENT); }
__device__ __forceinline__ unsigned xb_add(unsigned* p, unsigned v) { return __hip_atomic_fetch_add(p, v, __ATOMIC_RELAXED, __HIP_MEMORY_SCOPE_AGENT); }
__device__ __forceinline__ unsigned xb_xcc_id() { return (unsigned)__builtin_amdgcn_s_getreg((3 << 11) | 20) & 0xFu; }
#define XB_SPIN(cond, bar) do { unsigned _sp = 0; while (cond) { __builtin_amdgcn_s_sleep(1); \
    if ((++_sp & 255u) == 0u) { if (xb_ld(&(bar)[XB_TMO])) break; if (_sp > XB_SPIN_CAP) { atomicAdd(&(bar)[XB_TMO], 1u); break; } } } } while (0)

struct XcdBarrier {
    unsigned* bar; unsigned x;
    volatile LAS unsigned* st;
};

__device__ __forceinline__ XcdBarrier xcd_barrier_post(unsigned* bar, volatile LAS unsigned* st, const int tid) {
    XcdBarrier b; b.bar = bar; b.x = xb_xcc_id(); b.st = st;
    if (tid == 0) (void)xb_add(&bar[XB_XCNT(b.x)], 1u);
    return b;
}
__device__ __forceinline__ void xcd_barrier_complete(unsigned* bar, unsigned x, unsigned& nloc, unsigned& nx) {
    const unsigned G = gridDim.x * gridDim.y * gridDim.z;
    unsigned sum, cnt, mine, sp = 0u;
    for (;;) {
        sum = 0u; cnt = 0u; mine = 0u;
#pragma unroll
        for (unsigned j = 0; j < 16; ++j) { const unsigned c = xb_ld(&bar[XB_XCNT(j)]); sum += c; cnt += (c > 0u) ? 1u : 0u; mine = (j == x) ? c : mine; }
        if (sum == G) break;
        __builtin_amdgcn_s_sleep(1);
        if ((++sp & 255u) == 0u) { if (xb_ld(&bar[XB_TMO])) break; if (sp > XB_SPIN_CAP) { atomicAdd(&bar[XB_TMO], 1u); break; } }
    }
    nloc = mine > 0u ? mine : 1u; nx = cnt > 0u ? cnt : 1u;
}

__device__ __forceinline__ void xcd_barrier(const XcdBarrier& b, const int tid) {
    asm volatile("s_waitcnt vmcnt(0)" ::: "memory");
    __syncthreads();
    if (tid == 0) {
        unsigned* bar = b.bar;
        __builtin_amdgcn_s_waitcnt(0);
        unsigned nloc = b.st[0], nx = b.st[1];
        if (nloc == 0u) { xcd_barrier_complete(bar, b.x, nloc, nx); b.st[0] = nloc; b.st[1] = nx; }
        const unsigned old = xb_add(&bar[XB_XSUB(b.x)], 1u);
        const unsigned gen = old / nloc;
        if (old + 1u == (gen + 1u) * nloc) {
            __builtin_amdgcn_fence(__ATOMIC_RELEASE, "agent");
            asm volatile("s_waitcnt vmcnt(0)" ::: "memory");
            const unsigned og = xb_add(&bar[XB_TOP], 1u);
            const unsigned tg = og / nx;
            if (og + 1u == (tg + 1u) * nx) xb_add(&bar[XB_TOPGEN], 1u);
            else XB_SPIN(xb_ld(&bar[XB_TOPGEN]) == tg, bar);
            __builtin_amdgcn_fence(__ATOMIC_ACQUIRE, "agent");
            xb_add(&bar[XB_XGEN(b.x)], 1u);
            asm volatile("s_waitcnt vmcnt(0)" ::: "memory");
        } else {
            XB_SPIN(xb_ld(&bar[XB_XGEN(b.x)]) == gen, bar);
            __builtin_amdgcn_fence(__ATOMIC_ACQUIRE, "agent");
            asm volatile("s_waitcnt vmcnt(0)" ::: "memory");
        }
    }
    __syncthreads();
}
namespace mk {
constexpr int N_PHASES = 14;
#ifndef MK_N_LAUNCHES
#define MK_N_LAUNCHES 1
#endif
#ifndef MK_BAR_EXTRA
#define MK_BAR_EXTRA
#endif
#ifndef MK_CG_SYNC0
#define MK_CG_SYNC0 0
#endif

__device__ __forceinline__ int lane_now() { int l; asm volatile("v_mbcnt_lo_u32_b32 %0, -1, 0\n\tv_mbcnt_hi_u32_b32 %0, -1, %0" : "=v"(l)); return l; }

template <int LO, int HI>
__global__ void __launch_bounds__(NTHREADS, 2) mega_fwd(Params pv) {
    extern __shared__ __attribute__((aligned(16))) unsigned char lds_raw[];
    LAS unsigned char* lds = (LAS unsigned char*)lds_raw;
    const int G = gridDim.x, bx = blockIdx.x;
    const int vcu = (G % 8 == 0) ? (bx % 8) * (G / 8) + bx / 8 : bx;
    const int wv = __builtin_amdgcn_readfirstlane((int)threadIdx.x >> 6);
    const PPtr kp = (PPtr)__builtin_amdgcn_kernarg_segment_ptr();
    constexpr int lo = LO, hi = HI;
    constexpr bool multi = (HI - LO) > 1;
#define IN(k) (lo <= (k) && (k) < hi)
#define TIDNOW() (wv * 64 + lane_now())
#define PNOW() ({ PPtr q_ = kp; asm volatile("" : "+s"(q_)); q_; })
    XcdBarrier bar; bar.bar = nullptr; bar.x = 0; bar.st = nullptr;
    if constexpr (multi) {
        const int tid = TIDNOW();
        volatile LAS unsigned* st = (volatile LAS unsigned*)(lds + LDS_MISC + 8192);
        if (tid < 4) st[tid] = 0u;
        __syncthreads();
        bar = xcd_barrier_post((unsigned*)(PNOW()->ws + WS_BAR), st, tid);
    }
#define SEAM(k) do { if constexpr (IN(k) && IN((k) + 1)) { if constexpr (MK_CG_SYNC0 && (k) == LO) { cg::this_grid().sync(); } else { xcd_barrier(bar, TIDNOW()); MK_BAR_EXTRA } } } while (0)
    constexpr size_t TS1024 = (size_t)256 * 1024 * 2, TS512 = (size_t)256 * 512 * 2;

    if constexpr (IN(0)) { phase_prologue(PNOW(), lds, vcu, G, TIDNOW()); } SEAM(0);

    if constexpr (IN(1)) {
        const PPtr p = PNOW(); unsigned char* ws = p->ws;
        SchedG1 S{(const char*)p->out + OUT_XN, (const char*)ws + W_CAT, (const char*)p->out + OUT_MEMN, (const char*)ws + W_XKV, G, bx};
        EpiG1 E{ws, p->b_gate};
        pg8::gemm_phase<EpiG1, SchedG1, true, true>(lds, TIDNOW(), 1024, S, E);
        { constexpr int NU = 128 * 28 + 32; const int nmax = (NU + G - 1) / G, wfull = NU - (nmax - 1) * G;
          phase_convert_experts(PNOW(), lds, vcu, G, 3, TIDNOW(), wfull >= G ? 0 : wfull); }
    } SEAM(1);

    if constexpr (IN(2)) {
        phase_sgu<0>(PNOW(), lds, G, TIDNOW());
        phase_moba<1>(PNOW(), (char*)lds_raw, G, TIDNOW());
    } SEAM(2);

    if constexpr (IN(3)) {
        const PPtr p = PNOW(); unsigned char* ws = p->ws;
        SchedG2 S{(const char*)ws + WS_U, (const char*)ws + W_A, (const char*)ws + WS_Q, (const char*)ws + W_B, G, bx};
        EpiG2 E{ws + WS_G, (bf16*)(ws + WS_MERGED)};
        pg8::gemm_phase<EpiG2, SchedG2, true, true>(lds, TIDNOW(), 1024, S, E);
    } SEAM(3);

    if constexpr (IN(4)) {
        const PPtr p = PNOW(); unsigned char* ws = p->ws;
        SchedPlain S{(const char*)ws + WS_MERGED, (const char*)ws + W_O, 128, 4, G, bx, TS1024};
        EpiRes<true> E{p->x, (bf16*)(ws + WS_HB), (float*)(ws + WS_ST1), (bf16*)(ws + WS_HB), nullptr};
        pg8::gemm_phase<EpiRes<true>, SchedPlain, true, true>(lds, TIDNOW(), 1024, S, E);
    } SEAM(4);

    if constexpr (IN(5)) {
        const PPtr p = PNOW(); unsigned char* ws = p->ws;
        SchedPlain S{(const char*)ws + WS_HB, (const char*)ws + W_XQ, 128, 2, G, bx, TS1024};
        EpiScaleBf16 E{(bf16*)(ws + WS_Q2), XW, (const float*)(ws + WS_ST1)};
        pg8::gemm_phase<EpiScaleBf16, SchedPlain, true, true>(lds, TIDNOW(), 1024, S, E);
        asm volatile("s_waitcnt vmcnt(0)" ::: "memory"); __syncthreads();
        phase_xattn(PNOW(), (char*)lds_raw, G, TIDNOW(), nullptr);
    }
      SEAM(6);

    if constexpr (IN(7)) {
        const PPtr p = PNOW(); unsigned char* ws = p->ws;
        SchedPlain S{(const char*)ws + WS_Q2, (const char*)ws + W_XO, 128, 4, G, bx, TS512};
        EpiRes<false, true> E{nullptr, (bf16*)(ws + WS_HB), (float*)(ws + WS_ST2), (bf16*)(ws + WS_HB), ws + WS_XG8};
        pg8::gemm_phase<EpiRes<false, true>, SchedPlain, true, true>(lds, TIDNOW(), 512, S, E);
    } SEAM(7);

    if constexpr (IN(8)) {
        const PPtr p = PNOW(); unsigned char* ws = p->ws;
        init_slots(p, vcu, G, TIDNOW());
        SchedPlain S{(const char*)ws + WS_HB, (const char*)ws + W_R, 128, 1, G, bx, TS1024};
        EpiRouteFused E{(const float*)(ws + WS_ST2), p->b_rg, p->b_re, (int*)(ws + WS_EID), (float*)(ws + WS_WT), (int*)(ws + WS_CTL)};
        pg8::gemm_phase<EpiRouteFused, SchedPlain, false, true>(lds, TIDNOW(), 1024, S, E);
        __syncthreads();
        if (G > 128) phase_convert_experts(p, lds, vcu, G, 2, TIDNOW(), 128);
    } SEAM(8);

    if constexpr (IN(9)) {
        phase_dispatch(PNOW(), lds, vcu, G, TIDNOW());
        __syncthreads();
        phase_convert_experts(PNOW(), lds, vcu, G, 0, TIDNOW()); phase_convert_experts(PNOW(), lds, vcu, G, 1, TIDNOW()); if (G <= 128) phase_convert_experts(PNOW(), lds, vcu, G, 2, TIDNOW(), 0);
    }
      SEAM(10);

    if constexpr (IN(11)) {
        const PPtr p = PNOW(); unsigned char* ws = p->ws; const int tid = TIDNOW();
        build_tiles(p, lds, tid);
        SchedExpert S{(const char*)ws + WS_XG8, (const char*)ws + WS_WGU, 0, (size_t)1024 * 1024, (size_t)256 * 1024, (const LAS int*)(lds + LDS_MISC), G, bx, (const unsigned*)(ws + WS_SLOTOFF), __builtin_amdgcn_readfirstlane(((const LAS int*)(lds + LDS_MISC))[64]), (const LAS unsigned*)(lds + TABA_OFF)};
        preload_unit_tables(S, lds, tid, (const unsigned*)(ws + WS_SLOTOFF), (const unsigned*)(ws + WS_SLOTRS));
        EpiG7 E{(unsigned char*)p->out + OUT_HDN, (const float*)(ws + WS_SLOTRS), (const LAS float*)(lds + TABB_OFF)};
        pg8::gemm_phase<EpiG7, SchedExpert, true, true, true, true>(lds, tid, 512, S, E);
    } SEAM(11);

    if constexpr (IN(12)) {
        const PPtr p = PNOW(); unsigned char* ws = p->ws; const int tid = TIDNOW();
        build_tiles(p, lds, tid);
        SchedExpert S{(const char*)p->out + OUT_HDN, (const char*)p->out + OUT_WD, (size_t)256 * 512, (size_t)1024 * 512, (size_t)256 * 512, (const LAS int*)(lds + LDS_MISC), G, bx, nullptr, __builtin_amdgcn_readfirstlane(((const LAS int*)(lds + LDS_MISC))[64]), nullptr};
        preload_unit_tables(S, lds, tid, (const unsigned*)(ws + WS_SLOTP), nullptr);
        EpiG8 E{ws + WS_Y, (const int*)(ws + WS_SLOTP), (const LAS int*)(lds + TABA_OFF)};
        pg8::gemm_phase<EpiG8, SchedExpert, true, true, false, true>(lds, tid, 256, S, E);
    } SEAM(12);

    if constexpr (IN(13)) { phase_final(PNOW(), vcu, G, TIDNOW(), nullptr); }
    if constexpr (LO == 14) { phase_convert_experts(PNOW(), lds, vcu, G, 0, TIDNOW()); }
    if constexpr (LO == 15) { phase_convert_experts(PNOW(), lds, vcu, G, 1, TIDNOW()); }
    if constexpr (LO == 18) {
        const PPtr p = PNOW(); unsigned char* ws = p->ws;
        SchedPlain S{(const char*)ws + WS_Q2, (const char*)ws + W_XO, 128, 4, G, bx, TS512};
        EpiRes<false> E{nullptr, (bf16*)(ws + WS_HB), (float*)(ws + WS_VSTAT), (bf16*)(ws + WS_Q), nullptr};
        pg8::gemm_phase<EpiRes<false>, SchedPlain, true, true>(lds, TIDNOW(), 512, S, E);
    }
    if constexpr (LO == 19) { phase_xattn(PNOW(), (char*)lds_raw, G, TIDNOW(), (att::bf16*)(PNOW()->ws + WS_Q)); }
    if constexpr (LO == 20) { phase_final(PNOW(), vcu, G, TIDNOW(), (float*)(PNOW()->ws + WS_G)); }
    if constexpr (LO == 21) {
        const PPtr p = PNOW(); unsigned char* ws = p->ws;
        SchedG1 S{(const char*)p->out + OUT_XN, (const char*)ws + W_CAT, (const char*)p->out + OUT_MEMN, (const char*)ws + W_XKV, G, bx};
        EpiG1T<1> E{ws, p->b_gate};
        pg8::gemm_phase<EpiG1T<1>, SchedG1, true, true>(lds, TIDNOW(), 1024, S, E);
    }
    if constexpr (LO == 28) {
        const PPtr p = PNOW(); unsigned char* ws = p->ws;
        SchedG1 S{(const char*)p->out + OUT_XN, (const char*)ws + W_CAT, (const char*)p->out + OUT_MEMN, (const char*)ws + W_XKV, G, bx};
        EpiG1T<2> E{ws, p->b_gate};
        pg8::gemm_phase<EpiG1T<2>, SchedG1, true, true>(lds, TIDNOW(), 1024, S, E);
    }
    if constexpr (LO == 16) { phase_sgu<0>(PNOW(), lds, G, TIDNOW()); }
    if constexpr (LO == 23) { phase_sgu<1>(PNOW(), lds, G, TIDNOW()); }
    if constexpr (LO == 24) { phase_sgu<2>(PNOW(), lds, G, TIDNOW()); }
    if constexpr (LO == 25) { phase_sgu<3>(PNOW(), lds, G, TIDNOW()); }
    if constexpr (LO == 26) { phase_sgu<4>(PNOW(), lds, G, TIDNOW()); }
    if constexpr (LO == 27) { phase_sgu<5>(PNOW(), lds, G, TIDNOW()); }
    if constexpr (LO == 17) { phase_moba<1>(PNOW(), (char*)lds_raw, G, TIDNOW(), (att::bf16*)PNOW()->out); }
    if constexpr (LO == 22) { phase_moba<2>(PNOW(), (char*)lds_raw, G, TIDNOW(), (att::bf16*)PNOW()->out); }
#undef IN
#undef SEAM
#undef TIDNOW
#undef PNOW
}
}

extern "C" void kernel_launch(void* const* d_in, const int* in_sizes, int n_in, void* d_out, int out_size, void* d_ws, size_t ws_size, hipStream_t stream) {
    static int grid = 0;
    if (grid == 0) {
        if (n_in != 27 || out_size != mk::T * mk::D || ws_size < mk::WS_END) { fprintf(stderr, "kernel_launch: unexpected shapes (n_in %d, out %d, ws %zu)\n", n_in, out_size, ws_size); grid = -1; return; }
        int dev = 0, cus = 0;
        (void)hipGetDevice(&dev); (void)hipDeviceGetAttribute(&cus, hipDeviceAttributeMultiprocessorCount, dev);
        grid = cus;
#if MK_N_LAUNCHES == 1
        int per_cu = 0;
        (void)hipFuncSetAttribute((const void*)mk::mega_fwd<0, mk::N_PHASES>, hipFuncAttributeMaxDynamicSharedMemorySize, mk::LDS_BYTES);
        if (hipOccupancyMaxActiveBlocksPerMultiprocessor(&per_cu, (const void*)mk::mega_fwd<0, mk::N_PHASES>, mk::NTHREADS, mk::LDS_BYTES) != hipSuccess || per_cu < 1) {
            fprintf(stderr, "kernel_launch: occupancy query reports %d workgroups per CU; nothing launched\n", per_cu); grid = -1; return; }
        (void)hipGetLastError();
#endif
    }
    if (grid < 0) return;
    mk::Params p{};
    const float** pp = (const float**)&p;
    for (int i = 0; i < 27; ++i) pp[i] = (const float*)d_in[i];
    p.out = (float*)d_out; p.ws = (unsigned char*)d_ws;
#if MK_N_LAUNCHES == 1
    (void)hipMemsetAsync((unsigned char*)d_ws + mk::WS_BAR, 0, 16384, stream);
    void* args[] = {&p};
    hipError_t e = hipLaunchCooperativeKernel((const void*)mk::mega_fwd<0, mk::N_PHASES>, dim3(grid), dim3(mk::NTHREADS), args, mk::LDS_BYTES, stream);
    if (e != hipSuccess) fprintf(stderr, "cooperative launch failed: %s (grid %d)\n", hipGetErrorString(e), grid);
#else
#define MK_LAUNCH(k) do { static bool ad_ = false; if (!ad_) { ad_ = true; (void)hipFuncSetAttribute((const void*)mk::mega_fwd<k, k + 1>, hipFuncAttributeMaxDynamicSharedMemorySize, mk::LDS_BYTES); } \
        hipLaunchKernelGGL((mk::mega_fwd<k, k + 1>), dim3(grid), dim3(mk::NTHREADS), mk::LDS_BYTES, stream, p); } while (0)
#ifndef MK_X0
#define MK_X0
#endif
#ifndef MK_X1
#define MK_X1
#endif
#ifndef MK_X2
#define MK_X2
#endif
#ifndef MK_X3
#define MK_X3
#endif
#ifndef MK_X4
#define MK_X4
#endif
#ifndef MK_X5
#define MK_X5
#endif
#ifndef MK_X6
#define MK_X6
#endif
#ifndef MK_X7
#define MK_X7
#endif
#ifndef MK_X8
#define MK_X8
#endif
#ifndef MK_X9
#define MK_X9
#endif
#ifndef MK_X10
#define MK_X10
#endif
#ifndef MK_X11
#define MK_X11
#endif
#ifndef MK_X12
#define MK_X12
#endif
#ifndef MK_X13
#define MK_X13
#endif
#ifndef MK_X14
#define MK_X14
#endif
    MK_X0 MK_LAUNCH(0); MK_X1 MK_LAUNCH(1); MK_X2 MK_LAUNCH(2); MK_X3 MK_LAUNCH(3); MK_X4 MK_LAUNCH(4); MK_X5 MK_LAUNCH(5); MK_X6 MK_LAUNCH(6); MK_X7 MK_LAUNCH(7); MK_X8 MK_LAUNCH(8); MK_X9 MK_LAUNCH(9); MK_X10 MK_LAUNCH(10); MK_X11 MK_LAUNCH(11); MK_X12 MK_LAUNCH(12); MK_X13 MK_LAUNCH(13); MK_X14
#undef MK_LAUNCH
#endif
}
```

```cpp
#include <hip/hip_runtime.h>
#include <hip/hip_bf16.h>
#include <hip/hip_cooperative_groups.h>
#include <cstdio>
#include <cstdint>
namespace cg = cooperative_groups;
namespace pg8 {
#define PG8_LAS __attribute__((address_space(3)))
typedef unsigned short bf16_t;
typedef short bf16x8 __attribute__((ext_vector_type(8)));
typedef float f32x4 __attribute__((ext_vector_type(4)));
typedef unsigned u32x4 __attribute__((ext_vector_type(4)));
typedef int v8i32 __attribute__((ext_vector_type(8)));
constexpr int BM = 256, BK = 64, HALF = 128, HTB = HALF * BK * 2  , STAGE_BYTES = 8 * HTB, NXCD = 8, WGM = 8;

__host__ __device__ __forceinline__ int lds_byte(int r, int c) { const int st = (r >> 4) * 2 + (c >> 5), rr = r & 15, cc = c & 31, ob = rr * 64 + cc * 2; return st * 1024 + (ob ^ (((ob >> 9) & 1) << 5)); }
__host__ __device__ __forceinline__ void stage_rc(int b, int& R, int& C) { const int st = b / 1024, sb = b % 1024, swz = sb ^ (((sb >> 9) & 1) << 5); R = (st >> 1) * 16 + swz / 64; C = (st & 1) * 32 + (swz % 64) / 2; }
__host__ __device__ __forceinline__ int perm32(int rho) { const int n = rho >> 4, i = rho & 15; return 8 * (i >> 2) + 4 * n + (i & 3); }

struct Unit { int pm, pn; const char* A; const char* B; int aux; int ord; };
__device__ __forceinline__ unsigned cvt_pk_bf16(float lo, float hi) { unsigned r; asm volatile("v_cvt_pk_bf16_f32 %0, %1, %2" : "=v"(r) : "v"(lo), "v"(hi)); return r; }
template <class Epi, class Sched, bool ALIGN_EPI = false, bool SP2 = false, bool GATHER = false, bool FP8 = false>
__device__ __forceinline__ void gemm_phase(PG8_LAS unsigned char* lds, const int tid, const int K_, const Sched& S, const Epi& E) {
    int K = K_; if constexpr (FP8) asm volatile("" : "+s"(K));
    const int wid = __builtin_amdgcn_readfirstlane(tid >> 6), lane = tid & 63, wr = wid >> 2, wc = wid & 3, fr = lane & 15, fq = lane >> 4;
    const int nt = K / BK;
    unsigned voffA[2], voffB[2];
#pragma unroll
    for (int i = 0; i < 2; ++i) { int R, C; stage_rc(tid * 16 + i * 8192, R, C); const int Rb = Epi::PERM ? ((R & ~31) + perm32(R & 31)) : R;
        voffA[i] = (unsigned)(R * K + C) * 2u; voffB[i] = (unsigned)(Rb * K + C) * 2u; }
    unsigned vA[2][2], vAn[2][2];
    const size_t kstep = (size_t)(BK * 2);
    const size_t hstep = (size_t)HALF * K * 2;
#pragma unroll
    for (int h = 0; h < 2; ++h)
#pragma unroll
        for (int i = 0; i < 2; ++i) { vA[h][i] = voffA[i]; vAn[h][i] = vA[h][i]; }
#define PG8_ROWS(dst, u_) do { int gR[2]; unsigned gC[2]; { int l2_ = lane; if constexpr (FP8) asm volatile("v_mbcnt_lo_u32_b32 %0, -1, 0\n\tv_mbcnt_hi_u32_b32 %0, -1, %0" : "=v"(l2_)); \
        _Pragma("unroll") for (int i = 0; i < 2; ++i) { int R, C; stage_rc((wid * 64 + l2_) * 16 + i * 8192, R, C); gR[i] = R; gC[i] = (unsigned)C * 2u; } }     \
        unsigned x0, x1, x2, x3; \
        if constexpr (Sched::LDS_ROWS) { const PG8_LAS unsigned* lt_ = S.rowtab_lds(u_, lds); x0 = lt_[gR[0]]; x1 = lt_[gR[1]]; x2 = lt_[128 + gR[0]]; x3 = lt_[128 + gR[1]]; \
            asm volatile("s_waitcnt lgkmcnt(0)" : "+v"(x0), "+v"(x1), "+v"(x2), "+v"(x3) :: "memory"); }     \
        else { const unsigned* rt_ = S.rowtab(u_); x0 = rt_[gR[0]]; x1 = rt_[gR[1]]; x2 = rt_[128 + gR[0]]; x3 = rt_[128 + gR[1]]; \
        asm volatile("s_waitcnt vmcnt(0)" : "+v"(x0), "+v"(x1), "+v"(x2), "+v"(x3) :: "memory"); }     \
        dst[0][0] = x0 + gC[0]; dst[0][1] = x1 + gC[1]; dst[1][0] = x2 + gC[0]; dst[1][1] = x3 + gC[1]; } while (0)
    const unsigned ldsw = (unsigned)wid * 1024u;
    const int aoff = lds_byte(wr * 64 + fr, fq * 8), boff = lds_byte(wc * 32 + fr, fq * 8);
    int boffB = boff + 4 * HTB; if constexpr (FP8) asm volatile("" : "+v"(boffB));
#define PG8_SA(b, h) (((b) * 2 + (h)) * HTB)
#define PG8_SB(b, h) ((4 + (b) * 2 + (h)) * HTB)
#define PG8_STAGE(bufoff, gbase, voff) do { const char* gb_ = (const char*)(gbase); if constexpr (FP8) asm volatile("" : "+s"(gb_)); _Pragma("unroll") for (int _i = 0; _i < 2; ++_i) { \
        unsigned vo_ = (voff)[_i]; if constexpr (FP8) asm volatile("" : "+v"(vo_)); \
        __builtin_amdgcn_global_load_lds((const unsigned*)(gb_ + vo_), (PG8_LAS unsigned*)(lds + (bufoff) + ldsw + _i * 8192), 16, 0, 0); } } while (0)
#define PG8_AH1(p_) (GATHER ? (p_) : (p_) + hstep)
#define PG8_VH1(v_) (GATHER ? v_[1] : v_[0])
#define PG8_LDA8(dst, b, h) do { _Pragma("unroll") for (int m = 0; m < 4; ++m) dst[m] = PG8_CAT(*(const PG8_LAS bf16x8*)(lds + PG8_SA(b, h) + aoff + m * 2048), *(const PG8_LAS bf16x8*)(lds + PG8_SA(b, h) + aoff + m * 2048 + 1024)); } while (0)
#define PG8_LDB8(dst, b, h) do { _Pragma("unroll") for (int n = 0; n < 2; ++n) dst[n] = PG8_CAT(*(const PG8_LAS bf16x8*)(lds + boffB + ((b) * 2 + (h)) * HTB + n * 2048), *(const PG8_LAS bf16x8*)(lds + boffB + ((b) * 2 + (h)) * HTB + n * 2048 + 1024)); } while (0)
#define PG8_LDA(dst, b, h) do { if constexpr (FP8) { PG8_LDA8(dst##8, b, h); } else { _Pragma("unroll") for (int m = 0; m < 4; ++m) _Pragma("unroll") for (int k = 0; k < 2; ++k) dst[m][k] = *(const PG8_LAS bf16x8*)(lds + PG8_SA(b, h) + aoff + m * 2048 + k * 1024); } } while (0)
#define PG8_LDB(dst, b, h) do { if constexpr (FP8) { PG8_LDB8(dst##8, b, h); } else { _Pragma("unroll") for (int n = 0; n < 2; ++n) _Pragma("unroll") for (int k = 0; k < 2; ++k) dst[n][k] = *(const PG8_LAS bf16x8*)(lds + PG8_SB(b, h) + boff + n * 2048 + k * 1024); } } while (0)
#define PG8_CAT(x, y) __builtin_bit_cast(v8i32, __builtin_shufflevector(x, y, 0, 1, 2, 3, 4, 5, 6, 7, 8, 9, 10, 11, 12, 13, 14, 15))
#define PG8_MMA(ai, bj, At, Bt) do { __builtin_amdgcn_s_setprio(1); _Pragma("unroll") for (int m = 0; m < 4; ++m) _Pragma("unroll") for (int n = 0; n < 2; ++n) { \
        if constexpr (FP8) acc[ai][bj][m][n] = __builtin_amdgcn_mfma_scale_f32_16x16x128_f8f6f4(Bt##8[n], At##8[m], acc[ai][bj][m][n], 0, 0, 0, 0x7f7f7f7f, 0, 0x7f7f7f7f); \
        else { _Pragma("unroll") for (int k = 0; k < 2; ++k) acc[ai][bj][m][n] = __builtin_amdgcn_mfma_f32_16x16x32_bf16(Bt[n][k], At[m][k], acc[ai][bj][m][n], 0, 0, 0); } } __builtin_amdgcn_s_setprio(0); } while (0)
#define PG8_WAIT_V(n) asm volatile("s_waitcnt vmcnt(" #n ")" ::: "memory")
#define PG8_WAIT_L(n) asm volatile("s_waitcnt lgkmcnt(" #n ")" ::: "memory")
#define PG8_BAR __builtin_amdgcn_s_barrier()
#define PG8_SCHED do { if constexpr (!FP8) __builtin_amdgcn_sched_barrier(0); } while (0)
    Unit cur, nxt; int ui = 0;
    if (!S.next(0, cur)) return;
    f32x4 acc[2][2][4][2];
#pragma unroll
    for (int a = 0; a < 2; ++a)
#pragma unroll
        for (int b = 0; b < 2; ++b)
#pragma unroll
            for (int m = 0; m < 4; ++m)
#pragma unroll
                for (int n = 0; n < 2; ++n) acc[a][b][m][n] = (f32x4){0.f, 0.f, 0.f, 0.f};
    bf16x8 At[4][2], B0[2][2], B1[2][2]; v8i32 At8[4], B08[2], B18[2];
    const char* cA = cur.A; const char* cB = cur.B;
    if constexpr (GATHER) { PG8_ROWS(vA, cur); }
    S.a_ready(cur);
    if constexpr (SP2) {
        PG8_STAGE(PG8_SB(0, 0), cB, voffB); PG8_STAGE(PG8_SB(0, 1), cB + hstep, voffB); PG8_STAGE(PG8_SA(0, 0), cA, vA[0]); PG8_STAGE(PG8_SA(0, 1), PG8_AH1(cA), PG8_VH1(vA));
        if (wr == 1) PG8_BAR;
        PG8_WAIT_V(2); PG8_BAR;
        PG8_STAGE(PG8_SB(1, 0), cB + kstep, voffB); PG8_STAGE(PG8_SA(1, 0), cA + kstep, vA[0]); PG8_STAGE(PG8_SB(1, 1), cB + hstep + kstep, voffB);
        PG8_WAIT_V(6); PG8_BAR;
    } else {
        PG8_STAGE(PG8_SB(0, 0), cB, voffB); PG8_STAGE(PG8_SA(0, 0), cA, vA[0]); PG8_STAGE(PG8_SB(0, 1), cB + hstep, voffB); PG8_STAGE(PG8_SA(0, 1), PG8_AH1(cA), PG8_VH1(vA));
        if (wr == 1) PG8_BAR;
        PG8_WAIT_V(4); PG8_BAR;
        PG8_STAGE(PG8_SB(1, 0), cB + kstep, voffB); PG8_STAGE(PG8_SA(1, 0), cA + kstep, vA[0]); PG8_STAGE(PG8_SB(1, 1), cB + hstep + kstep, voffB);
        PG8_WAIT_V(6); PG8_BAR;
    }
    for (;;) {
        const bool has_next = S.next(ui + 1, nxt);
        const char* nA = has_next ? nxt.A : cA; const char* nB = has_next ? nxt.B : cB;
        if constexpr (GATHER) { if (has_next) { PG8_ROWS(vAn, nxt); } else { vAn[0][0] = vA[0][0]; vAn[0][1] = vA[0][1]; vAn[1][0] = vA[1][0]; vAn[1][1] = vA[1][1]; } }
        for (int t = 0; t < nt; t += 2) {
            const bool last = (t == nt - 2);
            const char* a1 = cA + (size_t)(t + 1) * kstep;
            const char* a2 = last ? nA : cA + (size_t)(t + 2) * kstep; const char* b2 = last ? nB : cB + (size_t)(t + 2) * kstep;
            const char* a3 = a2 + kstep; const char* b3 = b2 + kstep;
            unsigned vX[2][2];
#pragma unroll
            for (int h = 0; h < 2; ++h)
#pragma unroll
                for (int i = 0; i < 2; ++i) vX[h][i] = (GATHER && last) ? vAn[h][i] : vA[h][i];
            if (last && has_next) S.a_ready(nxt);
            if constexpr (SP2) {
            PG8_LDB(B0, 0, 0); PG8_LDB(B1, 0, 1); PG8_SCHED; PG8_LDA(At, 0, 0); PG8_STAGE(PG8_SA(1, 1), PG8_AH1(a1), PG8_VH1(vA));
            PG8_WAIT_V(8); PG8_WAIT_L(0); PG8_BAR; PG8_MMA(0, 0, At, B0); PG8_MMA(0, 1, At, B1); PG8_BAR; PG8_SCHED;
            PG8_LDA(At, 0, 1); PG8_STAGE(PG8_SB(0, 0), b2, voffB); PG8_STAGE(PG8_SB(0, 1), b2 + hstep, voffB); PG8_STAGE(PG8_SA(0, 0), a2, vX[0]);
            PG8_WAIT_V(8); PG8_WAIT_L(0); PG8_BAR; PG8_MMA(1, 0, At, B0); PG8_MMA(1, 1, At, B1); PG8_BAR; PG8_SCHED;
            PG8_LDB(B0, 1, 0); PG8_LDB(B1, 1, 1); PG8_SCHED; PG8_LDA(At, 1, 0); PG8_STAGE(PG8_SA(0, 1), PG8_AH1(a2), PG8_VH1(vX));
            PG8_WAIT_V(8); PG8_WAIT_L(0); PG8_BAR; PG8_MMA(0, 0, At, B0); PG8_MMA(0, 1, At, B1); PG8_BAR; PG8_SCHED;
            PG8_LDA(At, 1, 1); PG8_STAGE(PG8_SB(1, 0), b3, voffB); PG8_STAGE(PG8_SB(1, 1), b3 + hstep, voffB); PG8_STAGE(PG8_SA(1, 0), a3, vX[0]);
            PG8_WAIT_V(8); PG8_WAIT_L(0); PG8_BAR; PG8_MMA(1, 0, At, B0); PG8_MMA(1, 1, At, B1); PG8_BAR; PG8_SCHED;
            } else {
            PG8_LDB(B0, 0, 0); PG8_SCHED; PG8_LDA(At, 0, 0); PG8_STAGE(PG8_SA(1, 1), PG8_AH1(a1), PG8_VH1(vA));
            PG8_WAIT_L(8); PG8_BAR; PG8_WAIT_L(0); PG8_MMA(0, 0, At, B0); PG8_BAR; PG8_SCHED;
            PG8_LDB(B1, 0, 1); PG8_STAGE(PG8_SB(0, 0), b2, voffB);
            PG8_BAR; PG8_WAIT_L(0); PG8_MMA(0, 1, At, B1); PG8_BAR;
            PG8_LDA(At, 0, 1); PG8_STAGE(PG8_SA(0, 0), a2, vX[0]);
            PG8_BAR; PG8_WAIT_L(0); PG8_MMA(1, 0, At, B0); PG8_BAR; PG8_SCHED;
            PG8_STAGE(PG8_SB(0, 1), b2 + hstep, voffB);
            PG8_WAIT_V(6); PG8_BAR; PG8_MMA(1, 1, At, B1); PG8_BAR;
            PG8_LDB(B0, 1, 0); PG8_SCHED; PG8_LDA(At, 1, 0); PG8_STAGE(PG8_SA(0, 1), PG8_AH1(a2), PG8_VH1(vX));
            PG8_WAIT_L(8); PG8_BAR; PG8_WAIT_L(0); PG8_MMA(0, 0, At, B0); PG8_BAR; PG8_SCHED;
            PG8_LDB(B1, 1, 1); PG8_STAGE(PG8_SB(1, 0), b3, voffB);
            PG8_BAR; PG8_WAIT_L(0); PG8_MMA(0, 1, At, B1); PG8_BAR;
            PG8_LDA(At, 1, 1); PG8_STAGE(PG8_SA(1, 0), a3, vX[0]);
            PG8_BAR; PG8_WAIT_L(0); PG8_MMA(1, 0, At, B0); PG8_BAR; PG8_SCHED;
            PG8_STAGE(PG8_SB(1, 1), b3 + hstep, voffB);
            PG8_WAIT_V(6); PG8_BAR; PG8_MMA(1, 1, At, B1); PG8_BAR;
            }
        }
        if constexpr (ALIGN_EPI) { if (wr == 0) PG8_BAR; }
        bool chained = false;
        if constexpr (Epi::CHAIN) chained = E.mid(acc, cur, wr, wc, fr, fq);
        if (!chained) { if constexpr (!Epi::AFTER_DRAIN) {
            if constexpr (FP8) { int l2; asm volatile("v_mbcnt_lo_u32_b32 %0, -1, 0\n\tv_mbcnt_hi_u32_b32 %0, -1, %0" : "=v"(l2));
                E(acc, cur, wr, wc, l2 & 15, l2 >> 4); }
            else E(acc, cur, wr, wc, fr, fq);
            S.done(cur); } }
        if (!has_next) break;
        if (!chained) {
#pragma unroll
        for (int a = 0; a < 2; ++a)
#pragma unroll
            for (int b = 0; b < 2; ++b)
#pragma unroll
                for (int m = 0; m < 4; ++m)
#pragma unroll
                    for (int n = 0; n < 2; ++n) acc[a][b][m][n] = (f32x4){0.f, 0.f, 0.f, 0.f};
        }
        cur = nxt; cA = nA; cB = nB; ++ui;
        if constexpr (GATHER) { vA[0][0] = vAn[0][0]; vA[0][1] = vAn[0][1]; vA[1][0] = vAn[1][0]; vA[1][1] = vAn[1][1]; }
        if constexpr (ALIGN_EPI) { if (wr == 1) PG8_BAR; }
    }
    PG8_WAIT_V(0);
    if constexpr (!ALIGN_EPI) { if (wr == 0) PG8_BAR; }
    PG8_BAR;
    if constexpr (Epi::AFTER_DRAIN) { E.fused(acc, cur, wr, wc, fr, fq, lds, wid, lane); S.done(cur); }
#undef PG8_SA
#undef PG8_ROWS
#undef PG8_SB
#undef PG8_STAGE
#undef PG8_LDA
#undef PG8_LDA8
#undef PG8_AH1
#undef PG8_VH1
#undef PG8_LDB8
#undef PG8_LDB
#undef PG8_MMA
#undef PG8_CAT
#undef PG8_WAIT_V
#undef PG8_WAIT_L
#undef PG8_BAR
#undef PG8_SCHED
}
}
#define LAS __attribute__((address_space(3)))
#define GAS __attribute__((address_space(1)))
typedef unsigned short bf16;
typedef unsigned v4u __attribute__((ext_vector_type(4)));
typedef unsigned v2u __attribute__((ext_vector_type(2)));
typedef float f32x4 __attribute__((ext_vector_type(4)));
typedef float f32x2 __attribute__((ext_vector_type(2)));
typedef short bf16x8 __attribute__((ext_vector_type(8)));

namespace mk {
constexpr int D = 1024, NB_ = 8, S = 4096, T = NB_ * S;
constexpr int INW = 5120, NCAT = 7168;
constexpr int H = 8, DH = 128, NBLK = 16;
constexpr int XH = 4, XW = 512, MEM = 256;
constexpr int NE = 64, EH = 512;
constexpr int MAXTILES = 320;
constexpr int MAXSLOTS = MAXTILES * 256;
constexpr float EPS = 1e-6f;
constexpr int NWAVES = 8, NTHREADS = 512;

constexpr size_t MiB = 1u << 20;
constexpr size_t WS_U    = 0;
constexpr size_t WS_GV   = 64 * MiB;
constexpr size_t WS_Q    = 128 * MiB;
constexpr size_t WS_V    = 192 * MiB;
constexpr size_t WS_K    = 256 * MiB;
constexpr size_t WS_G    = 320 * MiB;
constexpr size_t WS_W    = 448 * MiB;
constexpr size_t W_CAT = WS_W, W_A = W_CAT + 14 * MiB, W_B = W_A + 2 * MiB, W_O = W_B + 2 * MiB, W_XQ = W_O + 2 * MiB, W_XKV = W_XQ + 1 * MiB,
                 W_XO = W_XKV + 2 * MiB, W_R = W_XO + 1 * MiB, W_END = W_R + 1 * MiB;
constexpr size_t WS_KVM  = W_END;
constexpr size_t WS_KPART = WS_KVM + 4 * MiB;
constexpr size_t WS_VSTAT = WS_KPART + 1 * MiB;
constexpr size_t WS_ST1  = WS_VSTAT + 2 * MiB;
constexpr size_t WS_ST2  = WS_ST1 + 2 * MiB;
constexpr size_t WS_RL   = WS_ST2 + 2 * MiB;
constexpr size_t WS_CNT  = WS_RL;
constexpr int CNT_STRIDE = 1024;
constexpr size_t WS_XIRS = WS_RL + 1 * MiB;
constexpr size_t WS_WSP  = WS_RL + 16 * MiB;
constexpr size_t WS_BTAB = WS_WSP + 256 * 1024;
constexpr size_t WS_CTL  = WS_BTAB + 4096;
constexpr size_t WS_EID  = WS_CTL + 4096;
constexpr size_t WS_WT   = WS_EID + 256 * 1024;
constexpr size_t WS_PSLOT = WS_WT + 256 * 1024;
constexpr size_t WS_SLOTP = WS_PSLOT + 256 * 1024;
constexpr size_t WS_SLOTRS = WS_SLOTP + 512 * 1024;
constexpr size_t WS_SLOTOFF = WS_SLOTRS + 512 * 1024;
constexpr size_t WS_BAR  = WS_SLOTOFF + 512 * 1024;
constexpr size_t WS_END  = WS_BAR + 16384;
static_assert(WS_END <= 512 * MiB, "workspace map");
constexpr size_t WS_MERGED = WS_GV;
constexpr size_t WS_HB   = WS_K;
constexpr size_t WS_Q2   = WS_V;
constexpr int SLOTCAP = 2 * T;
constexpr size_t WS_SOFF2 = WS_V;
constexpr size_t WS_SRS2  = WS_V + 16 * MiB;
constexpr size_t WS_SP2   = WS_V + 32 * MiB;
constexpr size_t WS_WGU  = WS_G;
constexpr size_t WS_XG8  = WS_U + 32 * MiB;
constexpr size_t WS_XN8 = WS_G + 64 * MiB;
constexpr size_t WS_WG8 = WS_G + 96 * MiB;
constexpr float WG_SCALE = 64.f;
constexpr float WGU_SCALE = 64.f, WD_SCALE = 32.f, HDN_SCALE = 4.f, Y_SCALE = 16.f;
constexpr size_t WS_XG   = WS_GV;
constexpr size_t WS_Y    = WS_GV;
constexpr size_t OUT_XN = 0;
constexpr size_t OUT_MEMN = 64 * MiB;
constexpr size_t OUT_WD  = 72 * MiB;
constexpr size_t OUT_HDN = 0;

constexpr int RING_BYTES = 131072;
constexpr int LDS_MISC = RING_BYTES;
constexpr int LDS_BYTES = 147456;

struct Params {
    const float *x, *mem, *norm_mix, *w_in, *w_gate, *b_gate, *sgu_norm, *w_spatial, *b_spatial, *w_branch_a, *w_branch_b, *rel_bias, *w_o, *norm_x, *norm_mem,
        *w_xq, *w_xkv, *w_xo, *norm_ffn, *w_rg, *b_rg, *w_re, *b_re, *w_e_gate, *w_e_up, *w_e_down, *norm_final;
    float* out; unsigned char* ws;
    int ph_lo, ph_hi;
};
typedef const Params __attribute__((address_space(4)))* PPtr;

__device__ __forceinline__ unsigned f2bf(float f) { unsigned u = __builtin_bit_cast(unsigned, f); return (u + 0x7fffu + ((u >> 16) & 1u)) >> 16; }
typedef __bf16 bf16x2_t __attribute__((ext_vector_type(2)));
__device__ __forceinline__ unsigned pk2(float lo, float hi) { const f32x2 v = {lo, hi}; const bf16x2_t b = __builtin_convertvector(v, bf16x2_t); return __builtin_bit_cast(unsigned, b); }
__device__ __forceinline__ unsigned pk4_fp8(float a, float b, float c, float d) { unsigned w = 0; w = __builtin_amdgcn_cvt_pk_fp8_f32(a, b, w, false); w = __builtin_amdgcn_cvt_pk_fp8_f32(c, d, w, true); return w; }
__device__ __forceinline__ f32x4 unpk4_fp8(unsigned w) { const f32x2 lo = __builtin_amdgcn_cvt_pk_f32_fp8(w, false), hi = __builtin_amdgcn_cvt_pk_f32_fp8(w, true); return (f32x4){lo.x, lo.y, hi.x, hi.y}; }
__device__ __forceinline__ unsigned pk4_u8(f32x4 g) {
    const unsigned q0 = (unsigned)(g[0] * 255.f + 0.5f), q1 = (unsigned)(g[1] * 255.f + 0.5f), q2 = (unsigned)(g[2] * 255.f + 0.5f), q3 = (unsigned)(g[3] * 255.f + 0.5f);
    return q0 | (q1 << 8) | (q2 << 16) | (q3 << 24); }
__device__ __forceinline__ f32x4 unpk4_u8(unsigned w) { return (f32x4){(float)(w & 0xffu), (float)((w >> 8) & 0xffu), (float)((w >> 16) & 0xffu), (float)(w >> 24)}; }
__device__ __forceinline__ v4u widen_rows(v2u a, v2u b) {
    const v2u s0 = __builtin_amdgcn_permlane16_swap(a.x, b.x, false, false), s1 = __builtin_amdgcn_permlane16_swap(a.y, b.y, false, false);
    return (v4u){s0.x, s1.x, s0.y, s1.y};
}
__device__ __forceinline__ float bf2f(unsigned short b) { return __builtin_bit_cast(float, (unsigned)b << 16); }
__device__ __forceinline__ float bflo(unsigned w) { return __builtin_bit_cast(float, w << 16); }
__device__ __forceinline__ float bfhi(unsigned w) { return __builtin_bit_cast(float, w & 0xffff0000u); }
__device__ __forceinline__ float wave_sum(float v) {
#pragma unroll
    for (int o = 1; o < 64; o <<= 1) v += __shfl_xor(v, o);
    return v;
}
__device__ __forceinline__ float fast_exp2(float x) { return __builtin_amdgcn_exp2f(x); }
__device__ __forceinline__ float fast_rcp(float x) { return __builtin_amdgcn_rcpf(x); }
__device__ __forceinline__ float gelu_tanh(float x) {
    const float k = -2.0f * 0.7978845608028654f * 1.4426950408889634f;
    const float u = x * (1.0f + 0.044715f * x * x);
    return x * fast_rcp(1.0f + fast_exp2(k * u));
}
__device__ __forceinline__ float sigmoid_f(float x) { return fast_rcp(1.0f + fast_exp2(-1.4426950408889634f * x)); }
}
namespace mk {
struct TrItem { const float* src; int ldn, k0, n0; bf16* dst; int ldk, drow; const float* kscale; bool nt; float fp8 = 0.f; };
__device__ __forceinline__ void tr_load(const TrItem& it, f32x4 (&v)[16], int lane) {
    const float* sp = it.src + (size_t)(it.k0 + (lane >> 4)) * it.ldn + it.n0 + 4 * (lane & 15);
#pragma unroll
    for (int i = 0; i < 16; ++i) v[i] = *(const f32x4*)(sp + (size_t)(4 * i) * it.ldn);
}
__device__ __forceinline__ void tr_store(const TrItem& it, const f32x4 (&v)[16], LAS float* scr, int lane) {
#pragma unroll
    for (int i = 0; i < 16; ++i) {
        const int kk = (lane >> 4) + 4 * i;
        f32x4 x = v[i];
        if (it.kscale) x = x * it.kscale[it.k0 + kk];
        if (it.fp8 != 0.f) x = x * it.fp8;
        LAS float* d = scr + kk * 65 + 4 * (lane & 15);
        d[0] = x.x; d[1] = x.y; d[2] = x.z; d[3] = x.w;
    }
    asm volatile("s_waitcnt lgkmcnt(0)" ::: "memory");
    if (it.fp8 != 0.f) {
#pragma unroll
        for (int j = 0; j < 4; ++j) {
            const int q = lane + 64 * j, n = q >> 2, c = q & 3;
            const LAS float* s = scr + (16 * c) * 65 + n;
            v4u o; o.x = pk4_fp8(s[0], s[65], s[2 * 65], s[3 * 65]); o.y = pk4_fp8(s[4 * 65], s[5 * 65], s[6 * 65], s[7 * 65]); o.z = pk4_fp8(s[8 * 65], s[9 * 65], s[10 * 65], s[11 * 65]); o.w = pk4_fp8(s[12 * 65], s[13 * 65], s[14 * 65], s[15 * 65]);
            __builtin_nontemporal_store(o, (v4u*)((unsigned char*)it.dst + (size_t)(it.drow + n) * it.ldk + it.k0 + 16 * c));
        }
        asm volatile("s_waitcnt lgkmcnt(0)" ::: "memory");
        return;
    }
#pragma unroll
    for (int j = 0; j < 8; ++j) {
        const int q = lane + 64 * j, n = q >> 3, c = q & 7;
        const LAS float* s = scr + (8 * c) * 65 + n;
        v4u o; o.x = pk2(s[0], s[65]); o.y = pk2(s[2 * 65], s[3 * 65]); o.z = pk2(s[4 * 65], s[5 * 65]); o.w = pk2(s[6 * 65], s[7 * 65]);
        if (it.nt) __builtin_nontemporal_store(o, (v4u*)(it.dst + (size_t)(it.drow + n) * it.ldk + it.k0 + 8 * c)); else *(v4u*)(it.dst + (size_t)(it.drow + n) * it.ldk + it.k0 + 8 * c) = o;
    }
    asm volatile("s_waitcnt lgkmcnt(0)" ::: "memory");
}
template <class Make> __device__ __forceinline__ void tr_run(int first, int stride, int n_items, const Make& make, LAS float* scr, int lane) {
    if (first >= n_items) return;
    f32x4 va[16], vb[16];
    TrItem ia = make(first), ib = ia;
    tr_load(ia, va, lane);
    for (int r = first; r < n_items; r += 2 * stride) {
        const bool hb = r + stride < n_items;
        if (hb) { ib = make(r + stride); tr_load(ib, vb, lane); }
        tr_store(ia, va, scr, lane);
        if (!hb) break;
        const bool ha = r + 2 * stride < n_items;
        if (ha) { ia = make(r + 2 * stride); tr_load(ia, va, lane); }
        tr_store(ib, vb, scr, lane);
        if (!ha) break;
    }
}
struct TrMat { const float* src; int K, N; bf16* dst; int ldk, row_off; const float* kscale; float fp8;
    __device__ __forceinline__ TrItem operator()(int r) const { const int nnb = N / 64, kb = r / nnb, nb = r % nnb; return TrItem{src, N, 64 * kb, 64 * nb, dst, ldk, row_off + 64 * nb, kscale, false, fp8}; } };
__device__ __forceinline__ void transpose_matrix(int& it, int gw, int NGW, const float* src, int K, int N, bf16* dst, int ldk, int row_off, const float* kscale, LAS float* scr, int lane, float fp8 = 0.f) {
    const int n_items = (K / 64) * (N / 64);
    int first = gw - (it % NGW); if (first < 0) first += NGW;
    tr_run(first, NGW, n_items, TrMat{src, K, N, dst, ldk, row_off, kscale, fp8}, scr, lane);
    it += n_items;
}
__device__ __forceinline__ void norm_row_bf16(const float* __restrict__ xrow, const float* __restrict__ g, bf16* __restrict__ orow, int lane, float* __restrict__ irs_out = nullptr, unsigned char* __restrict__ o8row = nullptr) {
    const f32x4* xr = (const f32x4*)xrow + lane;
    f32x4 v[4]; float s = 0.f;
#pragma unroll
    for (int j = 0; j < 4; ++j) { v[j] = xr[64 * j]; s += (v[j].x * v[j].x + v[j].y * v[j].y) + (v[j].z * v[j].z + v[j].w * v[j].w); }
    const float ms = wave_sum(s) * (1.f / 1024.f) + EPS; const float rstd = rsqrtf(ms);
    if (irs_out && lane == 0) *irs_out = sqrtf(ms);
    v2u* o8 = (v2u*)orow + lane;
#pragma unroll
    for (int j = 0; j < 4; ++j) { const f32x4 gg = ((const f32x4*)g)[lane + 64 * j]; v2u w; w.x = pk2(v[j].x * rstd * gg.x, v[j].y * rstd * gg.y); w.y = pk2(v[j].z * rstd * gg.z, v[j].w * rstd * gg.w); o8[64 * j] = w;
        if (o8row) ((unsigned*)o8row)[lane + 64 * j] = pk4_fp8(v[j].x * rstd * gg.x, v[j].y * rstd * gg.y, v[j].z * rstd * gg.z, v[j].w * rstd * gg.w); }
}
__device__ __forceinline__ int rel_bucket(int n) {
    if (n < 16) return n;
    const int large = 16 + (int)(logf((float)n / 16.0f) / 2.0794415416798357f * 16.0f);
    return large < 31 ? large : 31;
}

__device__ __forceinline__ void phase_prologue(PPtr p, LAS unsigned char* lds, int vcu, int G, const int tid) {
    const int lane = tid & 63, wave = tid >> 6;
    const int gw = vcu * NWAVES + wave, NGW = G * NWAVES;
    LAS float* scr = (LAS float*)(lds + wave * 16640);
    unsigned char* ws = p->ws;
    int it = 0;
    bf16* wcat = (bf16*)(ws + W_CAT);
    transpose_matrix(it, gw, NGW, p->w_in, D, INW, wcat, D, 0, nullptr, scr, lane);
    transpose_matrix(it, gw, NGW, p->w_gate, D, 2048, (bf16*)(ws + WS_WG8), D, 0, nullptr, scr, lane, WG_SCALE);
    transpose_matrix(it, gw, NGW, p->w_branch_a, D, D, (bf16*)(ws + W_A), D, 0, nullptr, scr, lane);
    transpose_matrix(it, gw, NGW, p->w_branch_b, D, D, (bf16*)(ws + W_B), D, 0, nullptr, scr, lane);
    transpose_matrix(it, gw, NGW, p->w_o, D, D, (bf16*)(ws + W_O), D, 0, nullptr, scr, lane);
    transpose_matrix(it, gw, NGW, p->w_xq, D, XW, (bf16*)(ws + W_XQ), D, 0, p->norm_x, scr, lane);
    transpose_matrix(it, gw, NGW, p->w_xkv, D, 1024, (bf16*)(ws + W_XKV), D, 0, nullptr, scr, lane);
    transpose_matrix(it, gw, NGW, p->w_xo, XW, D, (bf16*)(ws + W_XO), XW, 0, nullptr, scr, lane);
    bf16* xn = (bf16*)((unsigned char*)p->out + OUT_XN); bf16* memn = (bf16*)((unsigned char*)p->out + OUT_MEMN);
    float* xirs = (float*)(ws + WS_XIRS);
    for (int m = gw; m < T; m += NGW) norm_row_bf16(p->x + (size_t)m * D, p->norm_mix, xn + (size_t)m * D, lane, xirs + m, ws + WS_XN8 + (size_t)m * D);
    for (int m = gw; m < NB_ * MEM; m += NGW) norm_row_bf16(p->mem + (size_t)m * D, p->norm_mem, memn + (size_t)m * D, lane);
    const int gt = vcu * NTHREADS + tid, NGT = G * NTHREADS;
    {
        bf16* wr = (bf16*)(ws + W_R);
        for (int i = gt; i < 256 * 1024; i += NGT) { const int n = i >> 10, k = i & 1023; float v = 0.f;
            if (n < 8) v = p->w_rg[k * 8 + n] * p->norm_ffn[k]; else if (n < 72) v = p->w_re[k * 64 + (n - 8)] * p->norm_ffn[k];
            wr[i] = (bf16)f2bf(v); }
    }
    {
        bf16* wsp = (bf16*)(ws + WS_WSP);
        for (int i = gt; i < 8 * 128 * 128; i += NGT) { const int t = (i >> 7) & 127, s = i & 127; wsp[i] = (bf16)f2bf(s <= t ? p->w_spatial[i] : 0.f); }
    }
    {
        float* bt = (float*)(ws + WS_BTAB);
        for (int i = gt; i < 8 * 128; i += NGT) { const int h = i >> 7, dist = i & 127; bt[i] = p->rel_bias[rel_bucket(dist) * H + h] * 11.313708498984761f; }
    }
    {   int* cnt = (int*)(ws + WS_CNT); for (int i = gt; i < NE; i += NGT) cnt[i * CNT_STRIDE] = 0; }
}

struct TrGU { const float* wg; const float* wu; unsigned char* dst; const float* ns;
    __device__ __forceinline__ TrItem operator()(int r) const { const int nb = r & 7, kb = (r >> 3) & 15, which = (r >> 7) & 1, e = r >> 8;
        const float* base = (const float*)((uintptr_t)wg + (uintptr_t)which * ((uintptr_t)wu - (uintptr_t)wg));
        return TrItem{base + (size_t)e * D * EH, EH, 64 * kb, 64 * nb, (bf16*)(dst + (size_t)e * 1024 * D), D, (nb >> 1) * 256 + which * 128 + (nb & 1) * 64, ns, true, WGU_SCALE}; } };
struct TrD { const float* wd; unsigned char* dst;
    __device__ __forceinline__ TrItem operator()(int r) const { const int nb = r & 15, kb = (r >> 4) & 7, e = r >> 7;
        return TrItem{wd + (size_t)e * EH * D, D, 64 * kb, 64 * nb, (bf16*)(dst + (size_t)e * D * EH), EH, 64 * nb, nullptr, true, WD_SCALE}; } };
constexpr int WD_G1 = 6144, GU_EARLY = 4096;
__device__ __forceinline__ void phase_convert_experts(PPtr p, LAS unsigned char* lds, int vcu, int G, int part, const int tid, int wg0 = 0) {
    const int lane = tid & 63, wave = tid >> 6;
    const int gw = vcu * NWAVES + wave, NGW = G * NWAVES;
    LAS float* scr = (LAS float*)(lds + wave * 16640);
    unsigned char* wd8 = (unsigned char*)p->out + OUT_WD;
    const TrGU gu{p->w_e_gate, p->w_e_up, p->ws + WS_WGU, p->norm_ffn}; const TrD dn{p->w_e_down, wd8};
    const int bx = blockIdx.x, sw = (bx - wg0) * NWAVES + wave, nsw = (G - wg0) * NWAVES;
    if (part == 0) tr_run(GU_EARLY + gw, NGW, NE * 2 * 16 * 8, gu, scr, lane);
    else if (part == 3) { if (bx >= wg0) tr_run(sw, nsw, WD_G1, dn, scr, lane); }
    else if (bx >= wg0) { tr_run(WD_G1 + sw, nsw, NE * 8 * 16, dn, scr, lane); tr_run(sw, nsw, GU_EARLY, gu, scr, lane); }
}
}
namespace mk {
using pg8::Unit;
typedef const f32x4 (&AccRef)[2][2][4][2];

__device__ __forceinline__ void tile_order(int L, int nM, int nN, int& pm, int& pn) {
    const int nwg = nM * nN; int wgid = L;
    { const int q = nwg / 8, r = nwg % 8, xcd = wgid % 8, off = wgid / 8; wgid = (xcd < r ? xcd * (q + 1) : r * (q + 1) + (xcd - r) * q) + off; }
    const int nig = 8 * nN, gid = wgid / nig, fm = gid * 8, gsz = (nM - fm) < 8 ? (nM - fm) : 8;
    pm = fm + ((wgid % nig) % gsz); pn = (wgid % nig) / gsz;
}
struct SchedPlain {
    const char* A; const char* B; int nM, nN, G, c; size_t tstep;
    __device__ __forceinline__ bool next(int i, Unit& u) const {
        const long L = (long)i * G + c; if (L >= (long)nM * nN) return false;
        tile_order((int)L, nM, nN, u.pm, u.pn); u.A = A + (size_t)u.pm * tstep; u.B = B + (size_t)u.pn * tstep; u.aux = 0; return true; }
    __device__ __forceinline__ void a_ready(const Unit&) const {}
    __device__ __forceinline__ void done(const Unit&) const {}
};
struct SchedG1 {
    const char *A, *B, *A2, *B2; int G, c; int pn0, npn; bool kv; size_t ts;
    __device__ __forceinline__ bool next(int i, Unit& u) const {
        const long L = (long)i * G + c; const int N1 = 128 * npn;
        if (L < N1) { int pn; tile_order((int)L, 128, npn, u.pm, pn); u.pn = pn0 + pn; u.A = A + (size_t)u.pm * ts; u.B = B + (size_t)pn * ts; u.aux = 0; return true; }
        if (kv && L < N1 + 32) { const int l = (int)L - N1; u.pm = l >> 2; u.pn = l & 3; u.A = A2 + (size_t)u.pm * ts; u.B = B2 + (size_t)u.pn * ts; u.aux = 1; return true; }
        return false; }
    __device__ __forceinline__ void a_ready(const Unit&) const {}
    __device__ __forceinline__ void done(const Unit&) const {}
};
struct SchedG2 {
    const char *A0, *B0, *A1, *B1; int G, c;
    __device__ __forceinline__ bool next(int i, Unit& u) const {
        const int tile_i = i >> 1, pass = i & 1; const long L = (long)tile_i * G + c; if (L >= 128 * 4) return false;
        constexpr size_t ts = (size_t)256 * 1024 * 2;
        tile_order((int)L, 128, 4, u.pm, u.pn); u.A = (pass ? A1 : A0) + (size_t)u.pm * ts; u.B = (pass ? B1 : B0) + (size_t)u.pn * ts; u.aux = pass; return true; }
    __device__ __forceinline__ void a_ready(const Unit&) const {}
    __device__ __forceinline__ void done(const Unit&) const {}
};

#define EPI_ROWS(ai, m) (row0 + (ai) * 128 + (m) * 16)
__device__ __forceinline__ v4u pack8f(f32x4 a, f32x4 b) { v4u w; w.x = pk2(a[0], a[1]); w.y = pk2(a[2], a[3]); w.z = pk2(b[0], b[1]); w.w = pk2(b[2], b[3]); return w; }

static_assert(WS_U == 0 && WS_GV == 64 * MiB && WS_Q == 128 * MiB && WS_V == 192 * MiB && WS_K == 256 * MiB, "EpiG1 output offsets");
template <int PLAINP = 0> struct EpiG1T {
    static constexpr bool PERM = true, AFTER_DRAIN = false, CHAIN = false;
    unsigned char* ws; const float* b_gate; float gsc;
    __device__ __forceinline__ void operator()(AccRef acc, const Unit& u, int wr, int wc, int fr, int fq) const {
        if (PLAINP == 2) {
#pragma unroll
            for (int ai = 0; ai < 2; ++ai)
#pragma unroll
                for (int bj = 0; bj < 2; ++bj)
#pragma unroll
                    for (int m = 0; m < 4; ++m)
#pragma unroll
                        for (int n = 0; n < 2; ++n) asm volatile("" :: "v"(acc[ai][bj][m][n]));
            return; }
        const int row0 = u.pm * 256 + wr * 64 + fr, cl = wc * 32 + 8 * fq;
        if (u.aux == 1) {
#pragma unroll
            for (int ai = 0; ai < 2; ++ai)
#pragma unroll
                for (int m = 0; m < 4; ++m)
#pragma unroll
                    for (int bj = 0; bj < 2; ++bj) __builtin_nontemporal_store(pack8f(acc[ai][bj][m][0], acc[ai][bj][m][1]), (v4u*)((bf16*)(ws + WS_KVM) + (size_t)EPI_ROWS(ai, m) * 1024 + u.pn * 256 + bj * 128 + cl));
            return;
        }
        const int pn = PLAINP ? 8 + (u.pn % 4) : u.pn;
        if (pn >= 4 && pn < 8) {
            bf16* O = (bf16*)(ws + WS_GV); const int c0 = (pn & 3) * 256 + cl; const bool stats = true;
            float* vstat = (float*)(ws + WS_VSTAT);
#pragma unroll
            for (int ai = 0; ai < 2; ++ai)
#pragma unroll
                for (int m = 0; m < 4; ++m) { float ss = 0.f;
#pragma unroll
                    for (int bj = 0; bj < 2; ++bj) { f32x4 a = acc[ai][bj][m][0], b = acc[ai][bj][m][1];
#pragma unroll
                        for (int j = 0; j < 4; ++j) { a[j] = gelu_tanh(a[j]); b[j] = gelu_tanh(b[j]); ss += a[j] * a[j] + b[j] * b[j]; }
                        __builtin_nontemporal_store(pack8f(a, b), (v4u*)(O + (size_t)EPI_ROWS(ai, m) * 1024 + c0 + bj * 128)); }
                    if (stats) { ss += __shfl_xor(ss, 16); ss += __shfl_xor(ss, 32); if (fq == 0) vstat[(size_t)EPI_ROWS(ai, m) * 16 + (pn - 4) * 4 + wc] = ss; } }
        } else if (pn < 20) {
            const int reg = pn >> 2;
            bf16* O = (bf16*)(ws + (size_t)(reg == 0 ? 0 : reg == 2 ? 2 : reg == 3 ? 4 : 3) * (64 * MiB)); const int c0 = (pn & 3) * 256 + cl;
            float* kpart = (float*)(ws + WS_KPART);
#pragma unroll
            for (int ai = 0; ai < 2; ++ai)
#pragma unroll
                for (int m = 0; m < 4; ++m)
#pragma unroll
                    for (int bj = 0; bj < 2; ++bj) __builtin_nontemporal_store(pack8f(acc[ai][bj][m][0], acc[ai][bj][m][1]), (v4u*)(O + (size_t)EPI_ROWS(ai, m) * 1024 + c0 + bj * 128));
            if (pn >= 12 && pn < 16) {
#pragma unroll
                for (int bj = 0; bj < 2; ++bj)
#pragma unroll
                    for (int n = 0; n < 2; ++n) { f32x4 s = acc[0][bj][0][n];
#pragma unroll
                        for (int m = 1; m < 4; ++m) s = s + acc[0][bj][m][n];
#pragma unroll
                        for (int m = 0; m < 4; ++m) s = s + acc[1][bj][m][n];
#pragma unroll
                        for (int j = 0; j < 4; ++j) { float v = s[j]; v += __shfl_xor(v, 1); v += __shfl_xor(v, 2); v += __shfl_xor(v, 4); v += __shfl_xor(v, 8); s[j] = v; }
                        if (fr == 0) *(f32x4*)(kpart + ((size_t)u.pm * 2 + wr) * 1024 + c0 + bj * 128 + 4 * n) = s; }
            }
        } else {
            const int c0 = (pn - 20) * 256 + cl, odd = fq & 1, cw = c0 - 8 * odd;
#pragma unroll
            for (int bj = 0; bj < 2; ++bj) { const f32x4 b0 = *(const f32x4*)(b_gate + c0 + bj * 128), b1 = *(const f32x4*)(b_gate + c0 + bj * 128 + 4);
#pragma unroll
                for (int ai = 0; ai < 2; ++ai)
#pragma unroll
                    for (int mp = 0; mp < 2; ++mp) { v2u w8[2];
#pragma unroll
                        for (int q = 0; q < 2; ++q) { f32x4 a = acc[ai][bj][2 * mp + q][0] * gsc + b0, b = acc[ai][bj][2 * mp + q][1] * gsc + b1;
#pragma unroll
                            for (int j = 0; j < 4; ++j) { a[j] = sigmoid_f(a[j]); b[j] = sigmoid_f(b[j]); }
                            w8[q].x = pk4_u8(a); w8[q].y = pk4_u8(b); }
                        __builtin_nontemporal_store(widen_rows(w8[0], w8[1]), (v4u*)(ws + WS_G + (size_t)EPI_ROWS(ai, 2 * mp + odd) * 2048 + cw + bj * 128)); } }
        }
    }
};
typedef EpiG1T<0> EpiG1;
struct EpiG2 {
    static constexpr bool PERM = true, AFTER_DRAIN = false, CHAIN = true;
    const unsigned char* Gt; bf16* MG;
    __device__ __forceinline__ bool mid(f32x4 (&acc)[2][2][4][2], const Unit& u, int wr, int wc, int fr, int fq) const {
        if (u.aux != 0) return false;
        const int row0 = u.pm * 256 + wr * 64 + fr, c0 = u.pn * 256 + wc * 32 + 8 * fq;
#pragma unroll
        for (int ai = 0; ai < 2; ++ai) {
            v2u g0[4][2], g1[4][2];
#pragma unroll
            for (int m = 0; m < 4; ++m)
#pragma unroll
                for (int bj = 0; bj < 2; ++bj) { const size_t r = (size_t)EPI_ROWS(ai, m); g0[m][bj] = *(const v2u*)(Gt + r * 2048 + c0 + bj * 128); g1[m][bj] = *(const v2u*)(Gt + r * 2048 + 1024 + c0 + bj * 128); }
#pragma unroll
            for (int m = 0; m < 4; ++m)
#pragma unroll
                for (int bj = 0; bj < 2; ++bj) {
#pragma unroll
                    for (int n = 0; n < 2; ++n) { const f32x4 q0 = unpk4_u8(n ? g0[m][bj].y : g0[m][bj].x), q1 = unpk4_u8(n ? g1[m][bj].y : g1[m][bj].x);
#pragma unroll
                        for (int j = 0; j < 4; ++j) acc[ai][bj][m][n][j] *= q0[j] * fast_rcp(fmaxf(q1[j], 1e-30f)); } }
        }
        return true;
    }
    __device__ __forceinline__ void operator()(AccRef acc, const Unit& u, int wr, int wc, int fr, int fq) const {
        const int row0 = u.pm * 256 + wr * 64 + fr, c0 = u.pn * 256 + wc * 32 + 8 * fq;
        v2u gg[2][4][2];
#pragma unroll
        for (int ai = 0; ai < 2; ++ai)
#pragma unroll
            for (int m = 0; m < 4; ++m)
#pragma unroll
                for (int bj = 0; bj < 2; ++bj) gg[ai][m][bj] = *(const v2u*)(Gt + (size_t)EPI_ROWS(ai, m) * 2048 + 1024 + c0 + bj * 128);
#pragma unroll
        for (int ai = 0; ai < 2; ++ai)
#pragma unroll
            for (int m = 0; m < 4; ++m)
#pragma unroll
                for (int bj = 0; bj < 2; ++bj) { const size_t r = (size_t)EPI_ROWS(ai, m); const v2u g = gg[ai][m][bj];
                    const f32x4 qa = unpk4_u8(g.x), qb = unpk4_u8(g.y);
                    f32x4 a = acc[ai][bj][m][0], b = acc[ai][bj][m][1];
#pragma unroll
                    for (int j = 0; j < 4; ++j) { a[j] *= fmaxf(qa[j], 1e-30f) * (1.0f / 255.0f); b[j] *= fmaxf(qb[j], 1e-30f) * (1.0f / 255.0f); }
                    *(v4u*)(MG + r * 1024 + c0 + bj * 128) = pack8f(a, b); }
    }
};
template <bool BASE_F32, bool OUT8 = false, bool BASE_XN = false> struct EpiRes {
    static constexpr bool PERM = true, AFTER_DRAIN = false, CHAIN = false;
    const float* basef; bf16* HB; float* stat; bf16* HO; unsigned char* X8; const bf16* XN = nullptr; const float* irs = nullptr; const float* gmix = nullptr;
    __device__ __forceinline__ void operator()(AccRef acc, const Unit& u, int wr, int wc, int fr, int fq) const {
        const int row0 = u.pm * 256 + wr * 64 + fr, c0 = u.pn * 256 + wc * 32 + 8 * fq;
        f32x4 ig[2][2]; float irv[8];
        if constexpr (BASE_XN) {
#pragma unroll
            for (int bj = 0; bj < 2; ++bj)
#pragma unroll
                for (int n = 0; n < 2; ++n) { const f32x4 g = *(const f32x4*)(gmix + c0 + bj * 128 + 4 * n); ig[bj][n] = (f32x4){fast_rcp(g[0]), fast_rcp(g[1]), fast_rcp(g[2]), fast_rcp(g[3])}; }
#pragma unroll
            for (int k = 0; k < 8; ++k) irv[k] = irs[EPI_ROWS(k >> 2, k & 3)];
        }
#pragma unroll
        for (int ai = 0; ai < 2; ++ai) {
            f32x4 ba[4][2][2]; v4u bw[4][2]; v2u x8[2][2];
#pragma unroll
            for (int m = 0; m < 4; ++m)
#pragma unroll
                for (int bj = 0; bj < 2; ++bj) { const size_t o = (size_t)EPI_ROWS(ai, m) * 1024 + c0 + bj * 128;
                    if constexpr (BASE_F32) { ba[m][bj][0] = *(const f32x4*)(basef + o); ba[m][bj][1] = *(const f32x4*)(basef + o + 4); } else if constexpr (BASE_XN) { bw[m][bj] = *(const v4u*)(XN + o); } else { bw[m][bj] = *(const v4u*)(HB + o); } }
#pragma unroll
            for (int m = 0; m < 4; ++m) { const size_t r = (size_t)EPI_ROWS(ai, m); float ss = 0.f;
#pragma unroll
                for (int bj = 0; bj < 2; ++bj) { const size_t o = r * 1024 + c0 + bj * 128;
                    f32x4 a, b;
                    if constexpr (BASE_F32) { a = ba[m][bj][0]; b = ba[m][bj][1]; }
                    else { const v4u w = bw[m][bj]; a = (f32x4){bflo(w.x), bfhi(w.x), bflo(w.y), bfhi(w.y)}; b = (f32x4){bflo(w.z), bfhi(w.z), bflo(w.w), bfhi(w.w)};
                        if constexpr (BASE_XN) { const float ir = irv[ai * 4 + m]; a = a * ig[bj][0] * ir; b = b * ig[bj][1] * ir; } }
                    a = a + acc[ai][bj][m][0]; b = b + acc[ai][bj][m][1];
                    *(v4u*)(HO + o) = pack8f(a, b);
                    if constexpr (OUT8) { x8[m & 1][bj].x = pk4_fp8(a[0], a[1], a[2], a[3]); x8[m & 1][bj].y = pk4_fp8(b[0], b[1], b[2], b[3]); }
                    ss += (a[0] * a[0] + a[1] * a[1]) + (a[2] * a[2] + a[3] * a[3]) + (b[0] * b[0] + b[1] * b[1]) + (b[2] * b[2] + b[3] * b[3]); }
                ss += __shfl_xor(ss, 16); ss += __shfl_xor(ss, 32); if (fq == 0) stat[r * 16 + u.pn * 4 + wc] = ss;
                if constexpr (OUT8) { if (m & 1) {
#pragma unroll
                    for (int bj = 0; bj < 2; ++bj) *(v4u*)(X8 + (size_t)EPI_ROWS(ai, m - 1 + (fq & 1)) * 1024 + c0 - 8 * (fq & 1) + bj * 128) = widen_rows(x8[0][bj], x8[1][bj]); } } }
        }
    }
};
__device__ __forceinline__ float row_rstd(const float* stat, size_t r) {
    const f32x4* s = (const f32x4*)(stat + r * 16); const f32x4 a = s[0], b = s[1], c = s[2], d = s[3];
    const float t = ((a[0] + a[1]) + (a[2] + a[3])) + ((b[0] + b[1]) + (b[2] + b[3])) + ((c[0] + c[1]) + (c[2] + c[3])) + ((d[0] + d[1]) + (d[2] + d[3]));
    return rsqrtf(t * (1.0f / 1024.0f) + EPS);
}
struct EpiScaleBf16 {
    static constexpr bool PERM = true, AFTER_DRAIN = false, CHAIN = false;
    bf16* O; int ldo; const float* stat;
    __device__ __forceinline__ void operator()(AccRef acc, const Unit& u, int wr, int wc, int fr, int fq) const {
        const int row0 = u.pm * 256 + wr * 64 + fr, c0 = u.pn * 256 + wc * 32 + 8 * fq;
        float rsv[8];
#pragma unroll
        for (int k = 0; k < 8; ++k) rsv[k] = row_rstd(stat, (size_t)EPI_ROWS(k >> 2, k & 3));
#pragma unroll
        for (int ai = 0; ai < 2; ++ai)
#pragma unroll
            for (int m = 0; m < 4; ++m) { const size_t r = (size_t)EPI_ROWS(ai, m); const float rs = rsv[ai * 4 + m];
#pragma unroll
                for (int bj = 0; bj < 2; ++bj) *(v4u*)(O + r * ldo + c0 + bj * 128) = pack8f(acc[ai][bj][m][0] * rs, acc[ai][bj][m][1] * rs); }
    }
};
struct EpiRouter {
    static constexpr bool PERM = true, AFTER_DRAIN = false, CHAIN = false;
    float* RL; const float* stat;
    __device__ __forceinline__ void operator()(AccRef acc, const Unit& u, int wr, int wc, int fr, int fq) const {
        const int row0 = u.pm * 256 + wr * 64 + fr, c0 = wc * 32 + 8 * fq;
        float rsv[8];
#pragma unroll
        for (int k = 0; k < 8; ++k) rsv[k] = row_rstd(stat, (size_t)EPI_ROWS(k >> 2, k & 3));
#pragma unroll
        for (int ai = 0; ai < 2; ++ai)
#pragma unroll
            for (int m = 0; m < 4; ++m) { const size_t r = (size_t)EPI_ROWS(ai, m); const float rs = rsv[ai * 4 + m];
                *(f32x4*)(RL + r * 128 + c0) = acc[ai][0][m][0] * rs; *(f32x4*)(RL + r * 128 + c0 + 4) = acc[ai][0][m][1] * rs; }
    }
};
}
namespace mk {
typedef float f32x16 __attribute__((ext_vector_type(16)));
template <int NT> __device__ __forceinline__ void wave_mma_rows(const bf16* __restrict__ A, int lda, const bf16* __restrict__ Bt, int ldb, int K, f32x16 (&acc)[NT], int lane) {
    const int r32 = lane & 31, hi = lane >> 5;
    const bf16* ap = A + (size_t)r32 * lda + hi * 8; const bf16* bp = Bt + (size_t)r32 * ldb + hi * 8;
#pragma unroll
    for (int j = 0; j < NT; ++j)
#pragma unroll
        for (int r = 0; r < 16; ++r) acc[j][r] = 0.f;
#pragma unroll 16
    for (int k = 0; k < K; k += 16) {
        const bf16x8 a = *(const bf16x8*)(ap + k);
#pragma unroll
        for (int j = 0; j < NT; ++j) { const bf16x8 b = *(const bf16x8*)(bp + (size_t)(32 * j) * ldb + k); acc[j] = __builtin_amdgcn_mfma_f32_32x32x16_bf16(b, a, acc[j], 0, 0, 0); }
    }
}
__device__ __forceinline__ void phase_memkv(PPtr p, int vcu, int G, const int tid) {
    const int lane = tid & 63, wave = tid >> 6, r32 = lane & 31, hi = lane >> 5; const int gw = vcu * NWAVES + wave, NGW = G * NWAVES;
    const bf16* memn = (const bf16*)((const unsigned char*)p->out + OUT_MEMN); const bf16* w = (const bf16*)(p->ws + W_XKV); bf16* kvm = (bf16*)(p->ws + WS_KVM);
    for (int it = gw; it < 64 * 32; it += NGW) {
        const int rg = it >> 5, cg = it & 31;
        f32x16 acc[1];
        wave_mma_rows<1>(memn + (size_t)(32 * rg) * 1024, 1024, w + (size_t)(32 * cg) * 1024, 1024, 1024, acc, lane);
#pragma unroll
        for (int q = 0; q < 4; ++q) { v2u o; o.x = pk2(acc[0][4 * q], acc[0][4 * q + 1]); o.y = pk2(acc[0][4 * q + 2], acc[0][4 * q + 3]);
            *(v2u*)(kvm + (size_t)(32 * rg + r32) * 1024 + 32 * cg + 8 * q + 4 * hi) = o; }
    }
}
}
namespace att {
using bf16 = __hip_bfloat16;
constexpr int D = 128;
constexpr float THR = 8.f;
constexpr bool WSKIP = false;
constexpr float SCALE = 0.08838834764831845f;
constexpr int NW = 8, QBLK = 32, KVBLK = 64, QB = NW * QBLK;
constexpr int SHM_V = KVBLK * D * 2, SHM_K = KVBLK * D * 2;
constexpr int LDS_BYTES = 2 * SHM_V + 2 * SHM_K + NW * 64 * 4;
typedef short bf16x8 __attribute__((ext_vector_type(8)));
typedef short s16x4 __attribute__((ext_vector_type(4)));
typedef float f32x16 __attribute__((ext_vector_type(16)));
typedef float f32x4 __attribute__((ext_vector_type(4)));
typedef unsigned u32x4 __attribute__((ext_vector_type(4)));
template <class A, class Bt> struct same_t { static constexpr bool v = false; };
template <class A> struct same_t<A, A> { static constexpr bool v = true; };
#define KSWZ(row, colB) ((row) * 256 + ((colB) ^ (((row) & 7) << 4)))
#define SBAR() __builtin_amdgcn_sched_barrier(0)
__device__ __forceinline__ int v_st(int k, int c) { const int kk = (k & ~0xC) | ((k & 4) << 1) | ((k & 8) >> 1); return ((kk >> 3) * 4 + (c >> 5)) * 512 + ((kk & 7) * 32 + (c & 31)) * 2; }
__device__ __forceinline__ int v_rd_base(int lane) { return ((lane & 3) << 3) | (((lane >> 2) & 3) << 6) | (((lane >> 4) & 1) << 5) | (((lane >> 5) & 1) << 8); }
constexpr int v_rd_off(int d0, int ks, int half) { return d0 * 512 + ks * 4096 + half * 2048; }
__device__ __forceinline__ int crow(int r, int hi) { return (r & 3) + 8 * (r >> 2) + 4 * hi; }
__device__ __forceinline__ unsigned cvtpk(float lo, float hi) {
    unsigned r; asm volatile("v_cvt_pk_bf16_f32 %0, %1, %2" : "=v"(r) : "v"(lo), "v"(hi)); return r;
}
__device__ __forceinline__ bf16x8 pack8(f32x4 a, f32x4 b) {
    u32x4 w = {cvtpk(a[0], a[1]), cvtpk(a[2], a[3]), cvtpk(b[0], b[1]), cvtpk(b[2], b[3])};
    return *reinterpret_cast<bf16x8*>(&w);
}
template <class T> __device__ __forceinline__ bf16x8 load8(const T* p) {
    if constexpr (same_t<T, float>::v) { return pack8(*(const f32x4*)p, *(const f32x4*)(p + 4)); }
    else { return *reinterpret_cast<const bf16x8*>(p); }
}
__device__ __forceinline__ void mask_tile(f32x16& p0, f32x16& p1, int dq, unsigned W) {
    const float NEG = -__builtin_inff();
#pragma unroll
    for (int r = 0; r < 16; ++r) {
        const int c = (r & 3) + 8 * (r >> 2);
        if ((unsigned)(dq - c) >= W) p0[r] = NEG;
        if ((unsigned)(dq - c - 32) >= W) p1[r] = NEG;
    }
}
__device__ __forceinline__ void moba_mask_tile(f32x16& p0, f32x16& p1, int dq, const float* bt) {
    const float NEG = -__builtin_inff();
#pragma unroll
    for (int r = 0; r < 16; ++r) {
        const int c = (r & 3) + 8 * (r >> 2);
        const int d0 = dq - c, d1 = dq - c - 32;
        const float b0 = bt[d0 < 0 ? 0 : (d0 > 127 ? 127 : d0)], b1 = bt[d1 < 0 ? 0 : (d1 > 127 ? 127 : d1)];
        p0[r] = d0 < 0 ? NEG : p0[r] + b0;
        p1[r] = d1 < 0 ? NEG : p1[r] + b1;
        if ((r & 3) == 3) asm volatile("" ::: "memory");
    }
}
__device__ __forceinline__ void partialSM(f32x16& p0, f32x16& p1, float& m_reg, float& mn, float& alpha, float cadd = 0.f) {
    float pmax = p0[0]; for (int r = 1; r < 16; ++r) pmax = fmaxf(pmax, p0[r]); for (int r = 0; r < 16; ++r) pmax = fmaxf(pmax, p1[r]);
    { auto rr = __builtin_amdgcn_permlane32_swap(__float_as_uint(pmax), __float_as_uint(pmax), false, false);
      pmax = fmaxf(__uint_as_float(rr[0]), __uint_as_float(rr[1])); }
    pmax += cadd;
    constexpr float C2 = 1.4426950408889634f * SCALE;
    if (__builtin_expect(__all((pmax - m_reg) * SCALE <= THR), 1)) { mn = m_reg; alpha = 1.f; }
    else { mn = fmaxf(m_reg, pmax); alpha = __builtin_amdgcn_exp2f((m_reg - mn) * C2); m_reg = mn; }
    const float mnL = (cadd - mn) * C2;
    for (int r = 0; r < 16; ++r) p0[r] = fmaf(p0[r], C2, mnL); for (int r = 0; r < 16; ++r) p1[r] = fmaf(p1[r], C2, mnL);
    for (int r = 0; r < 16; ++r) p0[r] = __builtin_amdgcn_exp2f(p0[r]);
}
__device__ __forceinline__ void finishSM(f32x16& p0, f32x16& p1, float alpha, float& l_reg, bf16x8& pa0, bf16x8& pa1, bf16x8& pa2, bf16x8& pa3) {
    for (int r = 0; r < 16; ++r) p1[r] = __builtin_amdgcn_exp2f(p1[r]);
    float ps = 0; for (int r = 0; r < 16; ++r) ps += p0[r]; for (int r = 0; r < 16; ++r) ps += p1[r];
    { auto rr = __builtin_amdgcn_permlane32_swap(__float_as_uint(ps), __float_as_uint(ps), false, false);
      ps = __uint_as_float(rr[0]) + __uint_as_float(rr[1]); }
    l_reg = l_reg * alpha + ps;
#define PK4(P, B_, OUT) do { unsigned a0 = cvtpk(P[B_+0], P[B_+1]), a1 = cvtpk(P[B_+2], P[B_+3]);                          \
        unsigned b0 = cvtpk(P[B_+4], P[B_+5]), b1 = cvtpk(P[B_+6], P[B_+7]);                                             \
        auto r0 = __builtin_amdgcn_permlane32_swap(a0, b0, false, false); auto r1 = __builtin_amdgcn_permlane32_swap(a1, b1, false, false); \
        u32x4 w = {r0[0], r1[0], r0[1], r1[1]}; OUT = *reinterpret_cast<bf16x8*>(&w); } while (0)
    PK4(p0, 0, pa0); PK4(p0, 8, pa1); PK4(p1, 0, pa2); PK4(p1, 8, pa3);
#undef PK4
}
template <int KB, bool SK>
__device__ __forceinline__ void qkt(f32x16& p0, f32x16& p1, const char* K_lds, int r32, int hi, const bf16x8* qr, bool act) {
    if (SK && !act) { const float NEG = -__builtin_inff();
#pragma unroll
        for (int r = 0; r < 16; ++r) { p0[r] = NEG; p1[r] = NEG; } return; }
    p0 = f32x16{}; p1 = f32x16{};
    const char* kb[4];
#pragma unroll
    for (int dd = 0; dd < 4; ++dd) kb[dd] = K_lds + KB * SHM_K + KSWZ(r32, (dd * 16 + hi * 8) * 2);
#pragma unroll
    for (int d0 = 0; d0 < 8; ++d0) { const char* a = kb[d0 & 3] + (d0 >> 2) * 128;
        bf16x8 b0 = *reinterpret_cast<const bf16x8*>(a);
        bf16x8 b1 = *reinterpret_cast<const bf16x8*>(a + 32 * 256);
        p0 = __builtin_amdgcn_mfma_f32_32x32x16_bf16(b0, qr[d0], p0, 0, 0, 0);
        p1 = __builtin_amdgcn_mfma_f32_32x32x16_bf16(b1, qr[d0], p1, 0, 0, 0); }
}
template <int VB, bool SK>
__device__ __forceinline__ void pv_tile(f32x16* o, int vb0, bf16x8 pa0, bf16x8 pa1, bf16x8 pa2, bf16x8 pa3, bool act) {
    if (SK && !act) return;
#define TRRD(dst, off) asm volatile("ds_read_b64_tr_b16 %0, %1 offset:%2" : "=&v"(dst) : "v"(vb0), "i"(off) : "memory")
#define PV_D0(d0) do { s16x4 l0, l1, l2, l3, h0, h1, h2, h3; constexpr int b_ = VB * SHM_V + v_rd_off(d0, 0, 0);     \
        TRRD(l0, b_); TRRD(h0, b_ + 2048); TRRD(l1, b_ + 4096); TRRD(h1, b_ + 6144); TRRD(l2, b_ + 8192); TRRD(h2, b_ + 10240); TRRD(l3, b_ + 12288); TRRD(h3, b_ + 14336); \
        asm volatile("s_waitcnt lgkmcnt(0)" ::: "memory"); SBAR();                 \
        o[d0] = __builtin_amdgcn_mfma_f32_32x32x16_bf16(pa0, (bf16x8){l0[0], l0[1], l0[2], l0[3], h0[0], h0[1], h0[2], h0[3]}, o[d0], 0, 0, 0);   \
        o[d0] = __builtin_amdgcn_mfma_f32_32x32x16_bf16(pa1, (bf16x8){l1[0], l1[1], l1[2], l1[3], h1[0], h1[1], h1[2], h1[3]}, o[d0], 0, 0, 0);   \
        o[d0] = __builtin_amdgcn_mfma_f32_32x32x16_bf16(pa2, (bf16x8){l2[0], l2[1], l2[2], l2[3], h2[0], h2[1], h2[2], h2[3]}, o[d0], 0, 0, 0);   \
        o[d0] = __builtin_amdgcn_mfma_f32_32x32x16_bf16(pa3, (bf16x8){l3[0], l3[1], l3[2], l3[3], h3[0], h3[1], h3[2], h3[3]}, o[d0], 0, 0, 0); } while (0)
    PV_D0(0); PV_D0(1); PV_D0(2); PV_D0(3);
#undef PV_D0
#undef TRRD
}

__device__ __forceinline__ float cinit_moba(int kb, int cur_blk, unsigned selmask, int qlo, float b31) {
    const int n = kb >> 8;
    if (n != cur_blk && !((selmask >> n) & 1u)) return -__builtin_inff();
    return (kb + KVBLK - 1 + 113 > qlo) ? 0.f : b31;
}
template <class TIn, class TOut> struct BlockRef { const TIn* Q; const TIn* K; const TIn* V; TOut* O; int P0; const float* kp; const float* btg; int h; };
template <class TIn> struct Seam {
    bf16x8 qr[8];
    bf16x8 st_v0, st_v1, st_k0, st_k1; f32x4 sf0, sf1, sf2, sf3;
    f32x4 tq[16];
};
__device__ __forceinline__ int swa_jlo(int P0, int W) { const int lowk = P0 - W + 1; return lowk > 0 ? lowk / KVBLK : 0; }
#define ROW(p, k0, rr) ((p) + (size_t)(k0) * LDKV + (unsigned)((rr) * LDKV + sc))
#define VMW() asm volatile("s_waitcnt vmcnt(0)" ::: "memory")
#define VMWN(n) asm volatile("s_waitcnt vmcnt(%0)" :: "i"(n) : "memory")
#define SLOAD_H(Kp, Vp, k0) do { S.st_v0 = load8<TIn>(ROW(Vp, k0, sr)); S.st_v1 = load8<TIn>(ROW(Vp, k0, 32 + sr));              \
                         S.st_k0 = load8<TIn>(ROW(Kp, k0, sr)); S.st_k1 = load8<TIn>(ROW(Kp, k0, 32 + sr)); } while (0)
#define SWRITE_HK(bf) do { *(bf16x8*)(K_lds + (bf) * SHM_K + kws) = S.st_k0; *(bf16x8*)(K_lds + (bf) * SHM_K + kws + 32 * 256) = S.st_k1; } while (0)
#define SWRITE_HV(bf) do { *(bf16x8*)(V_lds + (bf) * SHM_V + vst0) = S.st_v0; *(bf16x8*)(V_lds + (bf) * SHM_V + vst1) = S.st_v1; } while (0)
#define SWRITE_H(bf) do { SWRITE_HV(bf); SWRITE_HK(bf); } while (0)
#define SLOAD_F(p, k0) do { S.sf0 = *(const f32x4*)ROW(p, k0, sr); S.sf1 = *(const f32x4*)(ROW(p, k0, sr) + 4);                \
                            S.sf2 = *(const f32x4*)ROW(p, k0, 32 + sr); S.sf3 = *(const f32x4*)(ROW(p, k0, 32 + sr) + 4); } while (0)
#define SWRITE_KF(bf) do { *(bf16x8*)(K_lds + (bf) * SHM_K + kws) = pack8(S.sf0, S.sf1); *(bf16x8*)(K_lds + (bf) * SHM_K + kws + 32 * 256) = pack8(S.sf2, S.sf3); } while (0)
#define SWRITE_VF(bf) do { *(bf16x8*)(V_lds + (bf) * SHM_V + vst0) = pack8(S.sf0, S.sf1); *(bf16x8*)(V_lds + (bf) * SHM_V + vst1) = pack8(S.sf2, S.sf3); } while (0)
template <class TIn, class TOut, int MODE, int LDQ, int LDKV>
__device__ __forceinline__ void causal_swa_prime(const BlockRef<TIn, TOut>& cur, int W, char* lds, Seam<TIn>& S, const int tid) {
    constexpr bool F32 = same_t<TIn, float>::v;
    const int wid = __builtin_amdgcn_readfirstlane(tid >> 6), lane = tid & 63, r32 = lane & 31, hi = lane >> 5;
    const int sr = tid >> 4, sc = (tid & 15) * 8, kws = KSWZ(sr, sc * 2); char* K_lds = lds + 2 * SHM_V;
    const int kb0 = swa_jlo(cur.P0, W) * KVBLK;
    for (int d0 = 0; d0 < 8; ++d0) S.qr[d0] = load8<TIn>(cur.Q + (unsigned)((wid * QBLK + r32) * LDQ + d0 * 16 + hi * 8));
    if constexpr (F32) { SLOAD_F((const float*)cur.K, kb0); VMW(); SWRITE_KF(0); SBAR(); SLOAD_F((const float*)cur.V, kb0); }
    else { SLOAD_H(cur.K, cur.V, kb0); VMW(); SWRITE_HK(0); }
    __syncthreads();
}
template <class TIn, class TOut, int MODE, int LDQ, int LDKV>
__device__ __forceinline__ void causal_swa_block(const BlockRef<TIn, TOut>& cur, const BlockRef<TIn, TOut>& nxt, int skv, int W, char* lds, Seam<TIn>& S, const int tid) {
    constexpr bool F32 = same_t<TIn, float>::v;
    const int wid = __builtin_amdgcn_readfirstlane(tid >> 6), lane = tid & 63, r32 = lane & 31, hi = lane >> 5;
    const int j_lo = swa_jlo(cur.P0, W);
    int j_hi = (cur.P0 + QB - 1) / KVBLK + 1; if (j_hi > skv / KVBLK) j_hi = skv / KVBLK;
    const int NT = j_hi - j_lo;
    const int kbn = swa_jlo(nxt.P0, W) * KVBLK;
    const int qlo = cur.P0 + wid * QBLK, qm = qlo + r32 - 4 * hi;
    char* V_lds = lds; char* K_lds = lds + 2 * SHM_V;
    float* ws = (float*)(lds + 2 * SHM_V + 2 * SHM_K) + wid * 64; float* li_l = ws, * al_l = ws + 32;
    float m_reg = -1e30f, l_reg = 0; f32x16 o[4] = {};
    const int sr = tid >> 4, sc = (tid & 15) * 8, vst0 = v_st(sr, sc), vst1 = v_st(32 + sr, sc), kws = KSWZ(sr, sc * 2);
    const int vb0 = (int)(uintptr_t)V_lds + v_rd_base(lane);
    const TIn* Kh = cur.K; const TIn* Vh = cur.V;
#define RESC(a) do { if (__any((a) < 1.f)) { if (hi == 0) al_l[r32] = (a); asm volatile("s_waitcnt lgkmcnt(0)" ::: "memory");              \
                     for (int d_ = 0; d_ < 4; ++d_) for (int r = 0; r < 16; ++r) o[d_][r] *= al_l[crow(r, hi)]; } } while (0)
#define KBASE(t) ((j_lo + (t)) * KVBLK)
#define ACT(t) (KBASE(t) <= qlo + QBLK - 1 && KBASE(t) + KVBLK - 1 >= qlo - W + 1)
#define MASKT(P0_, P1_, t) do { if constexpr (MODE == 1) { const int kb_ = KBASE(t); if (kb_ + KVBLK - 1 + 113 > qlo) moba_mask_tile(P0_, P1_, qm - kb_, btab); } \
        else if constexpr (MODE == 2) { const int kb_ = KBASE(t); if (kb_ + KVBLK - 1 > qlo) mask_tile(P0_, P1_, qm - kb_, (unsigned)W); } } while (0)
    constexpr int NQL = F32 ? 16 : 8;
    constexpr bool SK = WSKIP && !F32;
#define SEAM_K0() do { VMWN(NQL); if constexpr (F32) { SWRITE_KF(0); SBAR(); SLOAD_F((const float*)nxt.V, kbn); } else { SWRITE_HK(0); } SBAR(); } while (0)
    f32x16 pA0, pA1, pB0, pB1; float mnA, mnB, alA, alB; bf16x8 pa0, pa1, pa2, pa3;
    unsigned selmask = 0xFFFFFFFFu; float b31 = 0.f; const float* btab = nullptr; const int cur_blk = cur.P0 >> 8;
    if constexpr (MODE == 1) {
        float* kms = (float*)(lds + LDS_BYTES);
        float* btl = kms + 16 * 128;
        int tq = tid; asm volatile("" : "+v"(tq));
        const int hq = (tq >> 5) & 1;
        { const int n = tq >> 5, d4 = (tq & 31) * 4;
          if (n < cur_blk) { const float* k0 = cur.kp + ((size_t)n * 2) * 1024 + cur.h * 128 + d4; const f32x4 a = *(const f32x4*)k0, b = *(const f32x4*)(k0 + 1024); *(f32x4*)(kms + n * 128 + d4) = a + b; }
          if (tq < 128) btl[tq] = cur.btg[tq]; }
        __syncthreads();
        btab = btl; b31 = __builtin_bit_cast(float, __builtin_amdgcn_readfirstlane(__builtin_bit_cast(int, btl[127])));
        if (cur_blk <= 3) selmask = (1u << cur_blk) - 1u;
        else {
            float g[15];
#pragma unroll
            for (int n = 0; n < 15; ++n) { float s = -__builtin_inff();
                if (n < cur_blk) { s = 0.f;
#pragma unroll
                    for (int d0 = 0; d0 < 8; ++d0) { const bf16x8 q = S.qr[d0]; const float* kk = kms + n * 128 + d0 * 16 + hq * 8; const f32x4 k0 = *(const f32x4*)kk, k1 = *(const f32x4*)(kk + 4);
#pragma unroll
                        for (int j = 0; j < 4; ++j) { s = fmaf(__builtin_bit_cast(float, (unsigned)(unsigned short)q[j] << 16), k0[j], s); s = fmaf(__builtin_bit_cast(float, (unsigned)(unsigned short)q[4 + j] << 16), k1[j], s); } }
                    s += __shfl_xor(s, 32); }
                g[n] = s; }
            selmask = 0u;
#pragma unroll
            for (int r = 0; r < 3; ++r) { float bv = -__builtin_inff(); int bi = 0;
#pragma unroll
                for (int n = 0; n < 15; ++n) { const bool take = !((selmask >> n) & 1u) && g[n] > bv; bv = take ? g[n] : bv; bi = take ? n : bi; }
                selmask |= 1u << bi; }
        }
    }
#define CINIT(t) (MODE == 1 ? cinit_moba(KBASE(t), cur_blk, selmask, qlo, b31) : 0.f)
    if constexpr (F32) { VMW(); SWRITE_VF(0); SBAR(); } else { SWRITE_HV(0); SBAR(); }
    if (NT > 1) { if constexpr (F32) SLOAD_F((const float*)Kh, KBASE(1)); else SLOAD_H(Kh, Vh, KBASE(1)); }
    SBAR(); qkt<0, SK>(pA0, pA1, K_lds, r32, hi, S.qr, ACT(0));
    if constexpr (F32) { if (NT > 1) { VMW(); SWRITE_KF(1); SBAR(); SLOAD_F((const float*)Vh, KBASE(1)); } }
    MASKT(pA0, pA1, 0); partialSM(pA0, pA1, m_reg, mnA, alA, CINIT(0));
    if (NT > 1) { VMW(); if constexpr (F32) { SWRITE_VF(1); SBAR(); if (NT > 2) SLOAD_F((const float*)Kh, KBASE(2)); } else SWRITE_H(1); }
    __syncthreads();
#define HALF_STEP(PX0, PX1, mnX, alX, PY0, PY1, alY, t, KB, VB, SB) do {                                                      \
        SBAR(); qkt<KB, SK>(PX0, PX1, K_lds, r32, hi, S.qr, ACT(t));                                             \
        finishSM(PY0, PY1, alY, l_reg, pa0, pa1, pa2, pa3); SBAR();                                                           \
        if ((t) + 1 < NT) { if constexpr (F32) { VMW(); SWRITE_KF(SB); SBAR(); SLOAD_F((const float*)Vh, KBASE((t) + 1)); }  \
                            else { SLOAD_H(Kh, Vh, KBASE((t) + 1)); } SBAR(); }                                               \
        pv_tile<VB, SK>(o, vb0, pa0, pa1, pa2, pa3, ACT((t) - 1)); MASKT(PX0, PX1, (t)); partialSM(PX0, PX1, m_reg, mnX, alX, CINIT(t));                                        \
        __syncthreads();                                                                                                      \
        if ((t) + 1 < NT) { VMW(); if constexpr (F32) { SWRITE_VF(SB); SBAR(); if ((t) + 2 < NT) SLOAD_F((const float*)Kh, KBASE((t) + 2)); } \
                            else { SWRITE_H(SB); } }                                                                          \
        RESC(alX); __syncthreads(); } while (0)
    for (int t = 1; t + 1 < NT; t += 2) {
        HALF_STEP(pB0, pB1, mnB, alB, pA0, pA1, alA, t, 1, 0, 0);
        HALF_STEP(pA0, pA1, mnA, alA, pB0, pB1, alB, t + 1, 0, 1, 1);
    }
    const bool even = (NT & 1) == 0;
    if (even) { SBAR(); qkt<1, SK>(pB0, pB1, K_lds, r32, hi, S.qr, ACT(NT - 1)); SBAR(); }
#define QROW(e) (nxt.Q + (size_t)(wid * QBLK + r32) * LDQ + ((e) >> 1) * 16 + hi * 8 + ((e) & 1) * 4)
    if constexpr (F32) { SLOAD_F((const float*)nxt.K, kbn); SBAR();
#pragma unroll
        for (int e = 0; e < 8; ++e) S.tq[e] = *(const f32x4*)QROW(e); }
    else { SLOAD_H(nxt.K, nxt.V, kbn); SBAR();
#pragma unroll
        for (int d0 = 0; d0 < 8; ++d0) S.qr[d0] = load8<TIn>(nxt.Q + (unsigned)((wid * QBLK + r32) * LDQ + d0 * 16 + hi * 8)); }
    SBAR();
    finishSM(pA0, pA1, alA, l_reg, pa0, pa1, pa2, pa3); SBAR();
    if constexpr (F32) {
#pragma unroll
        for (int e = 8; e < 16; ++e) S.tq[e] = *(const f32x4*)QROW(e); SBAR(); }
#undef QROW
    pv_tile<0, SK>(o, vb0, pa0, pa1, pa2, pa3, ACT(even ? NT - 2 : NT - 1));
    if (even) { MASKT(pB0, pB1, NT - 1); partialSM(pB0, pB1, m_reg, mnB, alB, CINIT(NT - 1)); __syncthreads(); RESC(alB);
        finishSM(pB0, pB1, alB, l_reg, pa0, pa1, pa2, pa3); SBAR(); pv_tile<1, SK>(o, vb0, pa0, pa1, pa2, pa3, ACT(NT - 1)); }
    SBAR(); SEAM_K0();
    if (hi == 0) li_l[r32] = l_reg; asm volatile("s_waitcnt lgkmcnt(0)" ::: "memory");
    float rli[16];
#pragma unroll
    for (int r = 0; r < 16; ++r) rli[r] = __builtin_amdgcn_rcpf(li_l[crow(r, hi)]);
    TOut* Ow = cur.O;
#pragma unroll
    for (int r = 0; r < 16; ++r) { const int orow = crow(r, hi);
#pragma unroll
        for (int d0 = 0; d0 < 4; ++d0) { const float v = o[d0][r] * rli[r];
            if constexpr (same_t<TOut, float>::v) { Ow[(unsigned)((wid * QBLK + orow) * LDQ + d0 * 32 + r32)] = v; }
            else { const float vn = __shfl_xor(v, 1);
                   if ((r32 & 1) == 0) *(unsigned*)(Ow + (unsigned)((wid * QBLK + orow) * LDQ + d0 * 32 + r32)) = cvtpk(v, vn); } } }
    if constexpr (F32) {
#pragma unroll
        for (int d0 = 0; d0 < 8; ++d0) S.qr[d0] = pack8(S.tq[2 * d0], S.tq[2 * d0 + 1]); }
    __syncthreads();
#undef RESC
#undef KBASE
#undef ACT
#undef MASKT
#undef CINIT
#undef SEAM_K0
#undef HALF_STEP
}
#undef ROW
#undef VMW
#undef VMWN
#undef SLOAD_H
#undef SWRITE_HK
#undef SWRITE_HV
#undef SWRITE_H
#undef SLOAD_F
#undef SWRITE_KF
#undef SWRITE_VF
}
namespace mk {
typedef att::BlockRef<att::bf16, att::bf16> ARef;

__device__ __forceinline__ ARef moba_ref(PPtr p, int L, int pass, att::bf16* oalt = nullptr) {
    const int xcd = L & 7, kk = L >> 3, bh = xcd + 8 * (kk >> 3), pr = kk & 7, b = bh >> 3, h = bh & 7;
    const int qb = pass ? 15 - pr : pr;
    ARef r;
    att::bf16* Q = (att::bf16*)(p->ws + WS_Q); const att::bf16* K = (const att::bf16*)(p->ws + WS_K); const att::bf16* V = (const att::bf16*)(p->ws + WS_V);
    r.Q = Q + ((size_t)b * S + (size_t)qb * 256) * 1024 + h * 128; r.O = Q + ((size_t)b * S + (size_t)qb * 256) * 1024 + h * 128;
    r.K = K + (size_t)b * S * 1024 + h * 128; r.V = V + (size_t)b * S * 1024 + h * 128; r.P0 = qb * 256;
    if (oalt) r.O = oalt + ((size_t)b * S + (size_t)qb * 256) * 1024 + h * 128;
    r.kp = (const float*)(p->ws + WS_KPART) + (size_t)b * 16 * 2 * 1024; r.btg = (const float*)(p->ws + WS_BTAB) + h * 128; r.h = h;
    return r;
}
template <int MODE = 1> __device__ __forceinline__ void phase_moba(PPtr p, char* lds, int G, const int tid, att::bf16* oalt = nullptr) {
    constexpr int total = 512;
    int L = blockIdx.x; if (L >= total) return;
    int pass = 0;
    ARef cur = moba_ref(p, L, 0, oalt);
    att::Seam<att::bf16> Sm;
    att::causal_swa_prime<att::bf16, att::bf16, MODE, 1024, 1024>(cur, 1 << 30, lds, Sm, tid);
    for (;;) {
        const bool more_pass = pass == 0, more_item = L + G < total, last = !more_pass && !more_item;
        int passn = pass + 1, Ln = L;
        if (!more_pass) { passn = 0; Ln = more_item ? L + G : L; }
        const ARef nxt = last ? cur : moba_ref(p, Ln, passn, oalt);
        att::causal_swa_block<att::bf16, att::bf16, MODE, 1024, 1024>(cur, nxt, S, 1 << 30, lds, Sm, tid);
        if (last) break;
        cur = nxt; pass = passn; L = Ln;
    }
}
__device__ __forceinline__ bool xattn_ref(PPtr p, int k, int G, ARef& r, att::bf16* oalt) {
    const int L = (k >> 1) * G + (int)blockIdx.x; if (L >= 128 * 2) return false;
    int pm, pn; tile_order(L, 128, 2, pm, pn);
    const int b = pm >> 4, qb = pm & 15, xh = 2 * pn + (k & 1);
    att::bf16* Q = (att::bf16*)(p->ws + WS_Q2); const att::bf16* KV = (const att::bf16*)(p->ws + WS_KVM);
    r.Q = Q + ((size_t)b * S + (size_t)qb * 256) * XW + xh * 128; r.O = Q + ((size_t)b * S + (size_t)qb * 256) * XW + xh * 128;
    r.K = KV + (size_t)b * MEM * 1024 + xh * 128; r.V = KV + (size_t)b * MEM * 1024 + 512 + xh * 128; r.P0 = 256;
    if (oalt) r.O = oalt + ((size_t)b * S + (size_t)qb * 256) * XW + xh * 128;
    r.kp = nullptr; r.btg = nullptr; r.h = 0;
    return true;
}
__device__ __forceinline__ void phase_xattn(PPtr p, char* lds, int G, const int tid, att::bf16* oalt) {
    ARef cur, nxt;
    if (!xattn_ref(p, 0, G, cur, oalt)) return;
    att::Seam<att::bf16> Sm;
    att::causal_swa_prime<att::bf16, att::bf16, 0, 512, 1024>(cur, 1 << 30, lds, Sm, tid);
    for (int k = 0;; ++k) {
        const bool last = !xattn_ref(p, k + 1, G, nxt, oalt);
        if (last) nxt = cur;
        att::causal_swa_block<att::bf16, att::bf16, 0, 512, 1024>(cur, nxt, MEM, 1 << 30, lds, Sm, tid);
        if (last) break;
        cur = nxt;
    }
}

template <int VAR = 0> __device__ __forceinline__ void phase_sgu(PPtr p, LAS unsigned char* lds, int G, const int tid) {
    typedef short s16x4 __attribute__((ext_vector_type(4)));
    const int lane = tid & 63, wave = __builtin_amdgcn_readfirstlane(tid >> 6);
    bf16* U = (bf16*)(p->ws + WS_U); const bf16* GV = (const bf16*)(p->ws + WS_GV); const float* vstat = (const float*)(p->ws + WS_VSTAT);
    const bf16* WSP = (const bf16*)(p->ws + WS_WSP);
    constexpr int RS = 40;
    constexpr int NUNITS = (T / 128) * 8;
    LAS unsigned char* img = lds + wave * 5120;
    LAS float* rtab = (LAS float*)(lds + 8 * 5120);
    const int fr = lane & 15, kg = lane >> 4;
    const int bx = blockIdx.x;
    bf16x8 wf[20]; int g_have = -1;
    v4u uuA[4], uuB[4]; v4u gvA[4], gvB[4];
#define SGU_LOAD(unit_, uu_, gv_) do { const int g_ = (unit_) & 7, t0_ = ((unit_) >> 3) * 128; \
        _Pragma("unroll") for (int ip = 0; ip < 4; ++ip) uu_[ip] = *(const v4u*)(U + (size_t)(t0_ + 16 * (2 * ip + (kg & 1)) + fr) * 1024 + g_ * 128 + 16 * wave + 4 * (kg & ~1)); \
        _Pragma("unroll") for (int i = 0; i < 4; ++i) { if (VAR == 2) gv_[i] = (v4u){(unsigned)t0_, (unsigned)i, 1u, 2u}; else if (VAR == 5) gv_[i] = *(const v4u*)(GV + ((size_t)(unit_) * 8 + wave) * 2048 + (size_t)(i * 64 + lane) * 8); else gv_[i] = *(const v4u*)(GV + (size_t)(t0_ + (lane >> 1) + 32 * i) * 1024 + g_ * 128 + 16 * wave + (lane & 1) * 8); } } while (0)
#define SGU_UNIT(unit_, j_, uu_, gv_) do { const int g = (unit_) & 7, t0 = ((unit_) >> 3) * 128; \
        if (g != g_have) { const bf16* wg = WSP + (size_t)g * 128 * 128; int n_ = 0;     \
            _Pragma("unroll") for (int i = 0; i < 8; ++i) _Pragma("unroll") for (int ks = 0; ks < 4; ++ks) if (ks < (16 * i + 15) / 32 + 1) { wf[n_] = *(const bf16x8*)(wg + (size_t)(16 * i + fr) * 128 + 32 * ks + 8 * kg); ++n_; } \
            g_have = g; } \
        float bbv[8]; _Pragma("unroll") for (int i = 0; i < 8; ++i) bbv[i] = p->b_spatial[g * 128 + 16 * i + fr];     \
        const f32x4 n0 = *(const f32x4*)(p->sgu_norm + g * 128 + 16 * wave + (lane & 1) * 8), n1 = *(const f32x4*)(p->sgu_norm + g * 128 + 16 * wave + (lane & 1) * 8 + 4); \
        if (VAR != 4 && VAR != 5) { _Pragma("unroll") for (int i = 0; i < 4; ++i) { const int s_ = (lane >> 1) + 32 * i; const float rs = rtab[(j_) * 128 + s_]; const v4u w = gv_[i]; \
            v4u o; o.x = pk2(bflo(w.x) * rs * n0[0], bfhi(w.x) * rs * n0[1]); o.y = pk2(bflo(w.y) * rs * n0[2], bfhi(w.y) * rs * n0[3]); \
            o.z = pk2(bflo(w.z) * rs * n1[0], bfhi(w.z) * rs * n1[1]); o.w = pk2(bflo(w.w) * rs * n1[2], bfhi(w.w) * rs * n1[3]); \
            LAS unsigned char* d = img + s_ * RS + (lane & 1) * 16; *(LAS v2u*)d = (v2u){o.x, o.y}; *(LAS v2u*)(d + 8) = (v2u){o.z, o.w}; } } \
        asm volatile("s_waitcnt lgkmcnt(0)" ::: "memory"); \
        bf16x8 af[4];     \
        if (VAR == 4 || VAR == 5) { _Pragma("unroll") for (int ks = 0; ks < 4; ++ks) af[ks] = (bf16x8){(short)gv_[ks].x, 0, 0, 0, 0, 0, 0, 0}; } else \
        { const int q = (lane & 15) >> 2, pp = lane & 3; const LAS unsigned char* base = img + (8 * kg + q) * RS + pp * 8; \
          _Pragma("unroll") for (int ks = 0; ks < 4; ++ks) { s16x4 lo, hi; \
              asm volatile("ds_read_b64_tr_b16 %0, %1" : "=v"(lo) : "v"(base + (32 * ks) * RS) : "memory"); \
              asm volatile("ds_read_b64_tr_b16 %0, %1" : "=v"(hi) : "v"(base + (32 * ks + 4) * RS) : "memory"); \
              asm volatile("s_waitcnt lgkmcnt(0)" : "+v"(lo), "+v"(hi) :: "memory"); \
              af[ks] = (bf16x8){lo[0], lo[1], lo[2], lo[3], hi[0], hi[1], hi[2], hi[3]}; } } \
        __builtin_amdgcn_sched_barrier(0); \
        int n = 0; \
        _Pragma("unroll") for (int ip = 0; ip < 4; ++ip) { \
              \
            const v2u s0_ = __builtin_amdgcn_permlane16_swap(uu_[ip].x, uu_[ip].z, false, false), s1_ = __builtin_amdgcn_permlane16_swap(uu_[ip].y, uu_[ip].w, false, false); \
            const v2u ua = {s0_.x, s1_.x}, ub = {s0_.y, s1_.y}; v2u r2[2]; \
            _Pragma("unroll") for (int q = 0; q < 2; ++q) { const int i = 2 * ip + q; f32x4 acc = {0.f, 0.f, 0.f, 0.f}; \
                _Pragma("unroll") for (int ks = 0; ks < 4; ++ks) if (ks < (16 * i + 15) / 32 + 1) { acc = __builtin_amdgcn_mfma_f32_16x16x32_bf16(af[ks], wf[n], acc, 0, 0, 0); ++n; } \
                const float bb = bbv[i];     \
                const v2u uq = q ? ub : ua; \
                r2[q].x = pk2(gelu_tanh(bflo(uq.x)) * (acc[0] + bb), gelu_tanh(bfhi(uq.x)) * (acc[1] + bb)); r2[q].y = pk2(gelu_tanh(bflo(uq.y)) * (acc[2] + bb), gelu_tanh(bfhi(uq.y)) * (acc[3] + bb)); }     \
            *(v4u*)(U + (size_t)(t0 + 16 * (2 * ip + (kg & 1)) + fr) * 1024 + g * 128 + 16 * wave + 4 * (kg & ~1)) = widen_rows(r2[0], r2[1]); } } while (0)
    if (bx < NUNITS) SGU_LOAD(bx, uuA, gvA);
    { const int nun = (NUNITS - bx + G - 1) / G;
_Pragma("unroll 2")
      for (int e = tid; e < nun * 128; e += NTHREADS) { const int j = e >> 7, unit = bx + j * G; rtab[e] = row_rstd(vstat, (size_t)((unit >> 3) * 128 + (e & 127))); } }
    __syncthreads();
    if (bx < NUNITS) {
        int j = 0;
        for (int unit = bx; unit < NUNITS; unit += 2 * G, j += 2) {
            const bool hb = unit + G < NUNITS;
            if (hb) SGU_LOAD(unit + G, uuB, gvB);
            SGU_UNIT(unit, j, uuA, gvA);
            if (!hb) break;
            const bool ha = unit + 2 * G < NUNITS;
            if (ha) SGU_LOAD(unit + 2 * G, uuA, gvA);
            SGU_UNIT(unit + G, j + 1, uuB, gvB);
            if (!ha) break;
        }
    }
#undef SGU_LOAD
#undef SGU_UNIT
    __syncthreads();
}
}
namespace mk {
__device__ __forceinline__ void build_tiles(PPtr p, LAS unsigned char* lds, const int tid) {
    LAS int* tb = (LAS int*)(lds + LDS_MISC);
    const int* counts = (const int*)(p->ws + WS_CNT);
    if (tid < NE) {
        const int n = __hip_atomic_load(counts + tid * CNT_STRIDE, __ATOMIC_RELAXED, __HIP_MEMORY_SCOPE_AGENT), nt = (n + 255) >> 8;
        int incl = nt;
#pragma unroll
        for (int o = 1; o < 64; o <<= 1) { const int v = __shfl_up(incl, o); if (tid >= o) incl += v; }
        const int tl = incl - nt;
        tb[tid] = tl * 256; tb[448 + tid] = n;
        for (int i = 0; i < nt; ++i) tb[128 + tl + i] = tid;
        if (tid == NE - 1) tb[64] = incl;
    }
    __syncthreads();
}
template <class FP> __device__ __forceinline__ void route_token(FP rl, const float* __restrict__ b_rg, const float* __restrict__ b_re, int t, float* __restrict__ wt, LAS int* hist, int& e0, int& e1, int& r0, int& r1) {
    float g[8]; float gm = -3.0e38f; int gs = 0;
#pragma unroll
    for (int i = 0; i < 8; ++i) { g[i] = rl[i] + b_rg[i]; if (g[i] > gm) { gm = g[i]; gs = i; } }
    float gsum = 0.f;
#pragma unroll
    for (int i = 0; i < 8; ++i) gsum += __expf(g[i] - gm);
    const float pg = 1.0f / gsum;
    float e[8]; float em = -3.0e38f;
#pragma unroll
    for (int i = 0; i < 8; ++i) { e[i] = rl[8 + gs * 8 + i] + b_re[gs * 8 + i]; em = fmaxf(em, e[i]); }
    float esum = 0.f; float pe[8];
#pragma unroll
    for (int i = 0; i < 8; ++i) { pe[i] = __expf(e[i] - em); esum += pe[i]; }
#pragma unroll
    for (int i = 0; i < 8; ++i) pe[i] /= esum;
    int i0 = 0; float p0 = pe[0];
#pragma unroll
    for (int i = 1; i < 8; ++i) if (pe[i] > p0) { p0 = pe[i]; i0 = i; }
    int i1 = -1; float p1 = -1.0f;
#pragma unroll
    for (int i = 0; i < 8; ++i) if (i != i0 && pe[i] > p1) { p1 = pe[i]; i1 = i; }
    const float ps = p0 + p1;
    e0 = gs * 8 + i0; e1 = gs * 8 + i1;
    wt[2 * t] = pg * (p0 / ps); wt[2 * t + 1] = pg * (p1 / ps);
    r0 = __hip_atomic_fetch_add(hist + e0, 1, __ATOMIC_RELAXED, __HIP_MEMORY_SCOPE_WORKGROUP); r1 = __hip_atomic_fetch_add(hist + e1, 1, __ATOMIC_RELAXED, __HIP_MEMORY_SCOPE_WORKGROUP);
}
struct EpiRouteFused {
    static constexpr bool PERM = true, AFTER_DRAIN = true, CHAIN = false;
    const float* stat; const float* b_rg; const float* b_re; float* wt; int* counts; unsigned* soff2; float* srs2; int* sp2;
    __device__ __forceinline__ void fused(f32x4 (&acc)[2][2][4][2], const Unit& u, int wr, int wc, int fr, int fq, LAS unsigned char* lds, int wid, int lane) const {
        LAS float* L = (LAS float*)lds;
        LAS int* hist = (LAS int*)(lds + 256 * 73 * 4); LAS int* base = hist + NE;
        const int tid = wid * 64 + lane;
        if (tid < NE) hist[tid] = 0;
        const int row0 = u.pm * 256 + wr * 64 + fr;
        float rsv[8];
#pragma unroll
        for (int k = 0; k < 8; ++k) rsv[k] = row_rstd(stat, (size_t)EPI_ROWS(k >> 2, k & 3));
#pragma unroll
        for (int ai = 0; ai < 2; ++ai)
#pragma unroll
            for (int m = 0; m < 4; ++m) { const int rl = ai * 128 + wr * 64 + m * 16 + fr; const float rs = rsv[ai * 4 + m];
#pragma unroll
                for (int n = 0; n < 2; ++n)
#pragma unroll
                    for (int j = 0; j < 4; ++j) { const int col = 32 * wc + 8 * fq + 4 * n + j; if (col < 72) L[rl * 73 + col] = acc[ai][0][m][n][j] * rs; } }
        __syncthreads();
        int e0 = 0, e1 = 0, r0 = 0, r1 = 0; const int tok = u.pm * 256 + tid;
        if (tid < 256) route_token(L + tid * 73, b_rg, b_re, tok, wt, hist, e0, e1, r0, r1);
        __syncthreads();
        if (tid < NE) { const int c = hist[tid]; base[tid] = c ? atomicAdd(counts + tid * CNT_STRIDE, c) : 0; }
        __syncthreads();
        if (tid < 256) { const float rs = row_rstd(stat, (size_t)tok);
            const size_t k0 = (size_t)e0 * SLOTCAP + (size_t)(base[e0] + r0), k1 = (size_t)e1 * SLOTCAP + (size_t)(base[e1] + r1);
            soff2[k0] = (unsigned)tok * 1024u; srs2[k0] = rs; sp2[k0] = 2 * tok;
            soff2[k1] = (unsigned)tok * 1024u; srs2[k1] = rs; sp2[k1] = 2 * tok + 1; }
    }
};
constexpr int NPRE = 5, TABA_OFF = LDS_MISC + 2048, TABB_OFF = LDS_MISC + 8448;
struct SchedExpert {
    static constexpr bool LDS_ROWS = true;
    const char* A; const char* B; size_t a_tstep, b_estep, b_tstep; const LAS int* tb; int G, c; int nt;
    __device__ __forceinline__ bool next(int i, Unit& u) const {
        if (i >= NPRE) return false;
        const int L = i * G + c; if (L >= nt * 4) return false;
        int w = L; { const int nwg = nt * 4, q = nwg / 8, r = nwg % 8, xcd = w % 8, off = w / 8; w = (xcd < r ? xcd * (q + 1) : r * (q + 1) + (xcd - r) * q) + off; }
        const int ti = w >> 2, pn = w & 3, e = __builtin_amdgcn_readfirstlane(tb[128 + ti]);
        u.pm = ti; u.pn = pn; u.A = A + (size_t)ti * a_tstep; u.B = B + (size_t)e * b_estep + (size_t)pn * b_tstep; u.aux = e; u.ord = i; return true; }
    __device__ __forceinline__ const LAS unsigned* rowtab_lds(const Unit& u, LAS unsigned char* lds) const { return (const LAS unsigned*)(lds + TABA_OFF) + u.ord * 256; }
    __device__ __forceinline__ void a_ready(const Unit&) const {}
    __device__ __forceinline__ void done(const Unit&) const {}
};
__device__ __forceinline__ void preload_unit_tables(const SchedExpert& S, LAS unsigned char* lds, const int tid_, const unsigned* srcA, unsigned padA, const unsigned* srcB) {
    int tid = tid_; asm volatile("" : "+v"(tid));
    LAS unsigned* ta = (LAS unsigned*)(lds + TABA_OFF); LAS unsigned* tbb = (LAS unsigned*)(lds + TABB_OFF);
    __syncthreads();
    if (tid < 256) {
        unsigned a[NPRE], b[NPRE];
#pragma unroll
        for (int i = 0; i < NPRE; ++i) { Unit u; a[i] = padA; b[i] = 0u;
            if (S.next(i, u)) { const int e = u.aux, k = (u.pm * 256 - S.tb[e]) + tid;
                if (k < S.tb[448 + e]) { const size_t o = (size_t)e * SLOTCAP + k; a[i] = srcA[o]; if (srcB) b[i] = srcB[o]; } } }
#pragma unroll
        for (int i = 0; i < NPRE; ++i) { ta[i * 256 + tid] = a[i]; if (srcB) tbb[i * 256 + tid] = b[i]; }
    }
    __syncthreads();
}
struct EpiG7 {
    static constexpr bool PERM = true, AFTER_DRAIN = false, CHAIN = false;
    unsigned char* HDN; const LAS float* tabb;
    __device__ __forceinline__ void operator()(AccRef acc, const Unit& u, int wr, int wc, int fr, int fq) const {
        const int row0 = u.pm * 256 + wr * 64 + fr, c0 = u.pn * 128 + wc * 32 + 8 * fq;
        float lim = 448.f; asm volatile("" : "+s"(lim));
        const int odd = fq & 1, cw = c0 - 8 * odd;
#pragma unroll
        for (int ai = 0; ai < 2; ++ai) {
            float rsv[4];
#pragma unroll
            for (int k = 0; k < 4; ++k) rsv[k] = tabb[u.ord * 256 + wr * 64 + fr + ai * 128 + k * 16] * (1.0f / WGU_SCALE);
#pragma unroll
            for (int mp = 0; mp < 2; ++mp) { v2u w8[2];
#pragma unroll
                for (int q = 0; q < 2; ++q) { const int m = 2 * mp + q; const float rs = rsv[m];
                    f32x4 a = acc[ai][0][m][0] * rs, b = acc[ai][0][m][1] * rs; const f32x4 ua = acc[ai][1][m][0] * (rs * HDN_SCALE), ub = acc[ai][1][m][1] * (rs * HDN_SCALE);
#pragma unroll
                    for (int j = 0; j < 4; ++j) { a[j] = fminf(fmaxf(a[j] * sigmoid_f(a[j]) * ua[j], -lim), lim); b[j] = fminf(fmaxf(b[j] * sigmoid_f(b[j]) * ub[j], -lim), lim); }
                    w8[q].x = pk4_fp8(a[0], a[1], a[2], a[3]); w8[q].y = pk4_fp8(b[0], b[1], b[2], b[3]); }
                const size_t r = (size_t)EPI_ROWS(ai, 2 * mp + odd);
                *(v4u*)(HDN + r * EH + cw) = widen_rows(w8[0], w8[1]); }
        }
    }
};
struct EpiG8 {
    static constexpr bool PERM = true, AFTER_DRAIN = false, CHAIN = false;
    unsigned char* Y; const LAS int* taba;
    __device__ __forceinline__ void operator()(AccRef acc, const Unit& u, int wr, int wc, int fr, int fq) const {
        const int row0 = u.pm * 256 + wr * 64 + fr, c0 = u.pn * 256 + wc * 32 + 8 * fq;
        constexpr float sc = Y_SCALE / (HDN_SCALE * WD_SCALE);
        int prv[8];
#pragma unroll
        for (int k = 0; k < 8; ++k) prv[k] = taba[u.ord * 256 + wr * 64 + fr + (k >> 2) * 128 + (k & 3) * 16];
        const int odd = fq & 1, cw = c0 - 8 * odd;
#pragma unroll
        for (int ai = 0; ai < 2; ++ai)
#pragma unroll
            for (int mp = 0; mp < 2; ++mp) { const int pr = odd ? prv[ai * 4 + 2 * mp + 1] : prv[ai * 4 + 2 * mp];
#pragma unroll
                for (int bj = 0; bj < 2; ++bj) { v2u w8[2];
#pragma unroll
                    for (int q = 0; q < 2; ++q) { const f32x4 a = acc[ai][bj][2 * mp + q][0] * sc, b = acc[ai][bj][2 * mp + q][1] * sc; w8[q].x = pk4_fp8(a[0], a[1], a[2], a[3]); w8[q].y = pk4_fp8(b[0], b[1], b[2], b[3]); }
                    const v4u w16 = widen_rows(w8[0], w8[1]);
                    if (pr >= 0) *(v4u*)(Y + ((unsigned)pr * 1024u + (unsigned)(cw + bj * 128))) = w16; } }
    }
};
__device__ __forceinline__ void phase_final(PPtr p, int vcu, int G, const int tid, float* oalt) {
    const int lane = tid & 63, wave = tid >> 6; const int gw = vcu * NWAVES + wave, NGW = G * NWAVES;
    const unsigned char* Y = p->ws + WS_Y; const float* wt = (const float*)(p->ws + WS_WT); const bf16* HB = (const bf16*)(p->ws + WS_HB);
    float* outp = oalt ? oalt : p->out;
    f32x4 gg[2][2];
#pragma unroll
    for (int j = 0; j < 2; ++j) { gg[j][0] = *(const f32x4*)(p->norm_final + (lane + 64 * j) * 8); gg[j][1] = *(const f32x4*)(p->norm_final + (lane + 64 * j) * 8 + 4); }
    for (int t = gw; t < T; t += NGW) {
        const float w0 = wt[2 * t] * (1.0f / Y_SCALE), w1 = wt[2 * t + 1] * (1.0f / Y_SCALE);
        const v4u* hr = (const v4u*)(HB + (size_t)t * 1024) + lane;
        const v2u* y0 = (const v2u*)(Y + (size_t)(2 * t) * 1024) + lane; const v2u* y1 = (const v2u*)(Y + (size_t)(2 * t + 1) * 1024) + lane;
        v4u hv[2]; v2u av[2], bv[2];
#pragma unroll
        for (int j = 0; j < 2; ++j) { hv[j] = hr[64 * j]; av[j] = y0[64 * j]; bv[j] = y1[64 * j]; }
        f32x4 v[2][2]; float s = 0.f;
#pragma unroll
        for (int j = 0; j < 2; ++j) { const v4u h = hv[j]; const f32x4 a0 = unpk4_fp8(av[j].x), a1 = unpk4_fp8(av[j].y), b0 = unpk4_fp8(bv[j].x), b1 = unpk4_fp8(bv[j].y);
            v[j][0] = (f32x4){bflo(h.x) + (w0 * a0[0] + w1 * b0[0]), bfhi(h.x) + (w0 * a0[1] + w1 * b0[1]), bflo(h.y) + (w0 * a0[2] + w1 * b0[2]), bfhi(h.y) + (w0 * a0[3] + w1 * b0[3])};
            v[j][1] = (f32x4){bflo(h.z) + (w0 * a1[0] + w1 * b1[0]), bfhi(h.z) + (w0 * a1[1] + w1 * b1[1]), bflo(h.w) + (w0 * a1[2] + w1 * b1[2]), bfhi(h.w) + (w0 * a1[3] + w1 * b1[3])};
#pragma unroll
            for (int q = 0; q < 2; ++q) s += (v[j][q][0] * v[j][q][0] + v[j][q][1] * v[j][q][1]) + (v[j][q][2] * v[j][q][2] + v[j][q][3] * v[j][q][3]); }
        const float rstd = rsqrtf(wave_sum(s) * (1.f / 1024.f) + EPS);
        f32x4* orow = (f32x4*)(outp + (size_t)t * 1024);
#pragma unroll
        for (int j = 0; j < 2; ++j) { __builtin_nontemporal_store(v[j][0] * rstd * gg[j][0], orow + (lane + 64 * j) * 2); __builtin_nontemporal_store(v[j][1] * rstd * gg[j][1], orow + (lane + 64 * j) * 2 + 1); }
    }
}
}
#define XB_TMO      128
#define XB_XCNT(j)  (256  + 64 * (j))
#define XB_XSUB(j)  (1280 + 64 * (j))
#define XB_XGEN(j)  (2304 + 64 * (j))
#define XB_TOP      3328
#define XB_TOPGEN   3392
#define XCD_BAR_WORDS 3456
#define XB_SPIN_CAP (1u << 23)

__device__ __forceinline__ unsigned xb_ld(unsigned* p)              { return __hip_atomic_load(p, __ATOMIC_RELAXED, __HIP_MEMORY_SCOPE_AGENT); }
__device__ __forceinline__ unsigned xb_add(unsigned* p, unsigned v) { return __hip_atomic_fetch_add(p, v, __ATOMIC_RELAXED, __HIP_MEMORY_SCOPE_AGENT); }
__device__ __forceinline__ unsigned xb_xcc_id() { return (unsigned)__builtin_amdgcn_s_getreg((3 << 11) | 20) & 0xFu; }
#define XB_SPIN(cond, bar) do { unsigned _sp = 0; while (cond) { __builtin_amdgcn_s_sleep(1); \
    if ((++_sp & 255u) == 0u) { if (xb_ld(&(bar)[XB_TMO])) break; if (_sp > XB_SPIN_CAP) { atomicAdd(&(bar)[XB_TMO], 1u); break; } } } } while (0)

struct XcdBarrier {
    unsigned* bar; unsigned x;
    volatile LAS unsigned* st;
};

__device__ __forceinline__ XcdBarrier xcd_barrier_post(unsigned* bar, volatile LAS unsigned* st, const int tid) {
    XcdBarrier b; b.bar = bar; b.x = xb_xcc_id(); b.st = st;
    if (tid == 0) (void)xb_add(&bar[XB_XCNT(b.x)], 1u);
    return b;
}
__device__ __forceinline__ void xcd_barrier_complete(unsigned* bar, unsigned x, unsigned& nloc, unsigned& nx) {
    const unsigned G = gridDim.x * gridDim.y * gridDim.z;
    unsigned sum, cnt, mine, sp = 0u;
    for (;;) {
        sum = 0u; cnt = 0u; mine = 0u;
#pragma unroll
        for (unsigned j = 0; j < 16; ++j) { const unsigned c = xb_ld(&bar[XB_XCNT(j)]); sum += c; cnt += (c > 0u) ? 1u : 0u; mine = (j == x) ? c : mine; }
        if (sum == G) break;
        __builtin_amdgcn_s_sleep(1);
        if ((++sp & 255u) == 0u) { if (xb_ld(&bar[XB_TMO])) break; if (sp > XB_SPIN_CAP) { atomicAdd(&bar[XB_TMO], 1u); break; } }
    }
    nloc = mine > 0u ? mine : 1u; nx = cnt > 0u ? cnt : 1u;
}

__device__ __forceinline__ void xcd_barrier(const XcdBarrier& b, const int tid) {
    asm volatile("s_waitcnt vmcnt(0)" ::: "memory");
    __syncthreads();
    if (tid == 0) {
        unsigned* bar = b.bar;
        __builtin_amdgcn_s_waitcnt(0);
        unsigned nloc = b.st[0], nx = b.st[1];
        if (nloc == 0u) { xcd_barrier_complete(bar, b.x, nloc, nx); b.st[0] = nloc; b.st[1] = nx; }
        const unsigned old = xb_add(&bar[XB_XSUB(b.x)], 1u);
        const unsigned gen = old / nloc;
        if (old + 1u == (gen + 1u) * nloc) {
            __builtin_amdgcn_fence(__ATOMIC_RELEASE, "agent");
            asm volatile("s_waitcnt vmcnt(0)" ::: "memory");
            const unsigned og = xb_add(&bar[XB_TOP], 1u);
            const unsigned tg = og / nx;
            __builtin_amdgcn_fence(__ATOMIC_ACQUIRE, "agent");
            if (og + 1u == (tg + 1u) * nx) xb_add(&bar[XB_TOPGEN], 1u);
            else XB_SPIN(xb_ld(&bar[XB_TOPGEN]) == tg, bar);
            xb_add(&bar[XB_XGEN(b.x)], 1u);
            asm volatile("s_waitcnt vmcnt(0)" ::: "memory");
        } else {
            __builtin_amdgcn_fence(__ATOMIC_ACQUIRE, "agent");
            XB_SPIN(xb_ld(&bar[XB_XGEN(b.x)]) == gen, bar);
            asm volatile("s_waitcnt vmcnt(0)" ::: "memory");
        }
    }
    __syncthreads();
}
namespace mk {
constexpr int N_PHASES = 14;
#ifndef MK_N_LAUNCHES
#define MK_N_LAUNCHES 1
#endif
#ifndef MK_BAR_EXTRA
#define MK_BAR_EXTRA
#endif
#ifndef MK_CG_SYNC0
#define MK_CG_SYNC0 0
#endif

__device__ __forceinline__ int lane_now() { int l; asm volatile("v_mbcnt_lo_u32_b32 %0, -1, 0\n\tv_mbcnt_hi_u32_b32 %0, -1, %0" : "=v"(l)); return l; }

template <int LO, int HI>
__global__ void __launch_bounds__(NTHREADS, 2) mega_fwd(Params pv) {
    extern __shared__ __attribute__((aligned(16))) unsigned char lds_raw[];
    LAS unsigned char* lds = (LAS unsigned char*)lds_raw;
    const int G = gridDim.x, bx = blockIdx.x;
    const int vcu = (G % 8 == 0) ? (bx % 8) * (G / 8) + bx / 8 : bx;
    const int wv = __builtin_amdgcn_readfirstlane((int)threadIdx.x >> 6);
    const PPtr kp = (PPtr)__builtin_amdgcn_kernarg_segment_ptr();
    constexpr int lo = LO, hi = HI;
    constexpr bool multi = (HI - LO) > 1;
#define IN(k) (lo <= (k) && (k) < hi)
#define TIDNOW() (wv * 64 + lane_now())
#define PNOW() ({ PPtr q_ = kp; asm volatile("" : "+s"(q_)); q_; })
    XcdBarrier bar; bar.bar = nullptr; bar.x = 0; bar.st = nullptr;
    if constexpr (multi) {
        const int tid = TIDNOW();
        volatile LAS unsigned* st = (volatile LAS unsigned*)(lds + LDS_MISC + 8192);
        if (tid < 4) st[tid] = 0u;
        __syncthreads();
        bar = xcd_barrier_post((unsigned*)(PNOW()->ws + WS_BAR), st, tid);
    }
#define SEAM(k) do { if constexpr (IN(k) && IN((k) + 1)) { if constexpr (MK_CG_SYNC0 && (k) == LO) { cg::this_grid().sync(); } else { xcd_barrier(bar, TIDNOW()); MK_BAR_EXTRA } } } while (0)
    constexpr size_t TS1024 = (size_t)256 * 1024 * 2, TS512 = (size_t)256 * 512 * 2;

    if constexpr (IN(0)) { phase_prologue(PNOW(), lds, vcu, G, TIDNOW()); } SEAM(0);

    if constexpr (IN(1)) {
        const PPtr p = PNOW(); unsigned char* ws = p->ws;
        { SchedG1 S{(const char*)p->out + OUT_XN, (const char*)ws + W_CAT, (const char*)p->out + OUT_MEMN, (const char*)ws + W_XKV, G, bx, 0, 20, true, TS1024};
          EpiG1 E{ws, p->b_gate, 1.0f};
          pg8::gemm_phase<EpiG1, SchedG1, true, true>(lds, TIDNOW(), 1024, S, E); }
        { constexpr int NU = 128 * 20 + 32; const int nmax = (NU + G - 1) / G, wfull = NU - (nmax - 1) * G;
          phase_convert_experts(PNOW(), lds, vcu, G, 3, TIDNOW(), wfull >= G ? 0 : wfull); }
        __syncthreads();
        { SchedG1 S{(const char*)ws + WS_XN8, (const char*)ws + WS_WG8, nullptr, nullptr, G, bx, 20, 8, false, (size_t)256 * 1024};
          EpiG1 E{ws, p->b_gate, 1.0f / WG_SCALE};
          pg8::gemm_phase<EpiG1, SchedG1, true, true, false, true>(lds, TIDNOW(), 512, S, E); }
    } SEAM(1);

    if constexpr (IN(2)) {
        phase_sgu<0>(PNOW(), lds, G, TIDNOW());
        phase_moba<1>(PNOW(), (char*)lds_raw, G, TIDNOW());
    } SEAM(2);

    if constexpr (IN(3)) {
        const PPtr p = PNOW(); unsigned char* ws = p->ws;
        SchedG2 S{(const char*)ws + WS_U, (const char*)ws + W_A, (const char*)ws + WS_Q, (const char*)ws + W_B, G, bx};
        EpiG2 E{ws + WS_G, (bf16*)(ws + WS_MERGED)};
        pg8::gemm_phase<EpiG2, SchedG2, true, true>(lds, TIDNOW(), 1024, S, E);
    } SEAM(3);

    if constexpr (IN(4)) {
        const PPtr p = PNOW(); unsigned char* ws = p->ws;
        SchedPlain S{(const char*)ws + WS_MERGED, (const char*)ws + W_O, 128, 4, G, bx, TS1024};
        EpiRes<false, false, true> E{nullptr, (bf16*)(ws + WS_HB), (float*)(ws + WS_ST1), (bf16*)(ws + WS_HB), nullptr, (const bf16*)((const unsigned char*)p->out + OUT_XN), (const float*)(ws + WS_XIRS), p->norm_mix};
        pg8::gemm_phase<EpiRes<false, false, true>, SchedPlain, true, true>(lds, TIDNOW(), 1024, S, E);
    } SEAM(4);

    if constexpr (IN(5)) {
        const PPtr p = PNOW(); unsigned char* ws = p->ws;
        SchedPlain S{(const char*)ws + WS_HB, (const char*)ws + W_XQ, 128, 2, G, bx, TS1024};
        EpiScaleBf16 E{(bf16*)(ws + WS_Q2), XW, (const float*)(ws + WS_ST1)};
        pg8::gemm_phase<EpiScaleBf16, SchedPlain, true, true>(lds, TIDNOW(), 1024, S, E);
        asm volatile("s_waitcnt vmcnt(0)" ::: "memory"); __syncthreads();
        phase_xattn(PNOW(), (char*)lds_raw, G, TIDNOW(), nullptr);
    }
      SEAM(6);

    if constexpr (IN(7)) {
        const PPtr p = PNOW(); unsigned char* ws = p->ws;
        SchedPlain S{(const char*)ws + WS_Q2, (const char*)ws + W_XO, 128, 4, G, bx, TS512};
        EpiRes<false, true> E{nullptr, (bf16*)(ws + WS_HB), (float*)(ws + WS_ST2), (bf16*)(ws + WS_HB), ws + WS_XG8};
        pg8::gemm_phase<EpiRes<false, true>, SchedPlain, true, true>(lds, TIDNOW(), 512, S, E);
    } SEAM(7);

    if constexpr (IN(8)) {
        const PPtr p = PNOW(); unsigned char* ws = p->ws;
        SchedPlain S{(const char*)ws + WS_HB, (const char*)ws + W_R, 128, 1, G, bx, TS1024};
        EpiRouteFused E{(const float*)(ws + WS_ST2), p->b_rg, p->b_re, (float*)(ws + WS_WT), (int*)(ws + WS_CNT), (unsigned*)(ws + WS_SOFF2), (float*)(ws + WS_SRS2), (int*)(ws + WS_SP2)};
        pg8::gemm_phase<EpiRouteFused, SchedPlain, false, true>(lds, TIDNOW(), 1024, S, E);
        __syncthreads();
        phase_convert_experts(p, lds, vcu, G, 2, TIDNOW(), G > 128 ? 128 : 0);
    }
    if constexpr (IN(9)) {
        phase_convert_experts(PNOW(), lds, vcu, G, 0, TIDNOW());
    }
      SEAM(10);

    if constexpr (IN(11)) {
        const PPtr p = PNOW(); unsigned char* ws = p->ws; const int tid = TIDNOW();
        build_tiles(p, lds, tid);
        SchedExpert S{(const char*)ws + WS_XG8, (const char*)ws + WS_WGU, 0, (size_t)1024 * 1024, (size_t)256 * 1024, (const LAS int*)(lds + LDS_MISC), G, bx, __builtin_amdgcn_readfirstlane(((const LAS int*)(lds + LDS_MISC))[64])};
        preload_unit_tables(S, lds, tid, (const unsigned*)(ws + WS_SOFF2), 0u, (const unsigned*)(ws + WS_SRS2));
        EpiG7 E{(unsigned char*)p->out + OUT_HDN, (const LAS float*)(lds + TABB_OFF)};
        pg8::gemm_phase<EpiG7, SchedExpert, true, true, true, true>(lds, tid, 512, S, E);
    } SEAM(11);

    if constexpr (IN(12)) {
        const PPtr p = PNOW(); unsigned char* ws = p->ws; const int tid = TIDNOW();
        build_tiles(p, lds, tid);
        SchedExpert S{(const char*)p->out + OUT_HDN, (const char*)p->out + OUT_WD, (size_t)256 * 512, (size_t)1024 * 512, (size_t)256 * 512, (const LAS int*)(lds + LDS_MISC), G, bx, __builtin_amdgcn_readfirstlane(((const LAS int*)(lds + LDS_MISC))[64])};
        preload_unit_tables(S, lds, tid, (const unsigned*)(ws + WS_SP2), 0xffffffffu, nullptr);
        EpiG8 E{ws + WS_Y, (const LAS int*)(lds + TABA_OFF)};
        pg8::gemm_phase<EpiG8, SchedExpert, true, true, false, true>(lds, tid, 256, S, E);
    } SEAM(12);

    if constexpr (IN(13)) { phase_final(PNOW(), vcu, G, TIDNOW(), nullptr); }
    if constexpr (LO == 14) { phase_convert_experts(PNOW(), lds, vcu, G, 0, TIDNOW()); }
    if constexpr (LO == 15) { phase_convert_experts(PNOW(), lds, vcu, G, 2, TIDNOW(), 0); }
    if constexpr (LO == 18) {
        const PPtr p = PNOW(); unsigned char* ws = p->ws;
        SchedPlain S{(const char*)ws + WS_Q2, (const char*)ws + W_XO, 128, 4, G, bx, TS512};
        EpiRes<false> E{nullptr, (bf16*)(ws + WS_HB), (float*)(ws + WS_VSTAT), (bf16*)(ws + WS_Q), nullptr};
        pg8::gemm_phase<EpiRes<false>, SchedPlain, true, true>(lds, TIDNOW(), 512, S, E);
    }
    if constexpr (LO == 19) { phase_xattn(PNOW(), (char*)lds_raw, G, TIDNOW(), (att::bf16*)(PNOW()->ws + WS_Q)); }
    if constexpr (LO == 20) { phase_final(PNOW(), vcu, G, TIDNOW(), (float*)(PNOW()->ws + WS_G)); }
    if constexpr (LO == 21) {
        const PPtr p = PNOW(); unsigned char* ws = p->ws;
        SchedG1 S{(const char*)p->out + OUT_XN, (const char*)ws + W_CAT, (const char*)p->out + OUT_MEMN, (const char*)ws + W_XKV, G, bx, 0, 20, true, TS1024};
        EpiG1T<1> E{ws, p->b_gate, 1.0f};
        pg8::gemm_phase<EpiG1T<1>, SchedG1, true, true>(lds, TIDNOW(), 1024, S, E);
    }
    if constexpr (LO == 28) {
        const PPtr p = PNOW(); unsigned char* ws = p->ws;
        SchedG1 S{(const char*)p->out + OUT_XN, (const char*)ws + W_CAT, (const char*)p->out + OUT_MEMN, (const char*)ws + W_XKV, G, bx, 0, 20, true, TS1024};
        EpiG1T<2> E{ws, p->b_gate, 1.0f};
        pg8::gemm_phase<EpiG1T<2>, SchedG1, true, true>(lds, TIDNOW(), 1024, S, E);
    }
    if constexpr (LO == 16) { phase_sgu<0>(PNOW(), lds, G, TIDNOW()); }
    if constexpr (LO == 23) { phase_sgu<1>(PNOW(), lds, G, TIDNOW()); }
    if constexpr (LO == 24) { phase_sgu<2>(PNOW(), lds, G, TIDNOW()); }
    if constexpr (LO == 25) { phase_sgu<3>(PNOW(), lds, G, TIDNOW()); }
    if constexpr (LO == 26) { phase_sgu<4>(PNOW(), lds, G, TIDNOW()); }
    if constexpr (LO == 27) { phase_sgu<5>(PNOW(), lds, G, TIDNOW()); }
    if constexpr (LO == 17) { phase_moba<1>(PNOW(), (char*)lds_raw, G, TIDNOW(), (att::bf16*)PNOW()->out); }
    if constexpr (LO == 22) { phase_moba<2>(PNOW(), (char*)lds_raw, G, TIDNOW(), (att::bf16*)PNOW()->out); }
#undef IN
#undef SEAM
#undef TIDNOW
#undef PNOW
}
}

extern "C" void kernel_launch(void* const* d_in, const int* in_sizes, int n_in, void* d_out, int out_size, void* d_ws, size_t ws_size, hipStream_t stream) {
    static int grid = 0;
    if (grid == 0) {
        if (n_in != 27 || out_size != mk::T * mk::D || ws_size < mk::WS_END) { fprintf(stderr, "kernel_launch: unexpected shapes (n_in %d, out %d, ws %zu)\n", n_in, out_size, ws_size); grid = -1; return; }
        int dev = 0, cus = 0;
        (void)hipGetDevice(&dev); (void)hipDeviceGetAttribute(&cus, hipDeviceAttributeMultiprocessorCount, dev);
        grid = cus;
        if (cus * mk::NPRE < mk::MAXTILES * 4) { fprintf(stderr, "kernel_launch: %d CUs; the expert GEMM phases keep the slot tables of at most %d units per workgroup in LDS (needs >= %d workgroups)\n", cus, mk::NPRE, (mk::MAXTILES * 4 + mk::NPRE - 1) / mk::NPRE); grid = -1; return; }
#if MK_N_LAUNCHES == 1
        int per_cu = 0;
        (void)hipFuncSetAttribute((const void*)mk::mega_fwd<0, mk::N_PHASES>, hipFuncAttributeMaxDynamicSharedMemorySize, mk::LDS_BYTES);
        if (hipOccupancyMaxActiveBlocksPerMultiprocessor(&per_cu, (const void*)mk::mega_fwd<0, mk::N_PHASES>, mk::NTHREADS, mk::LDS_BYTES) != hipSuccess || per_cu < 1) {
            fprintf(stderr, "kernel_launch: occupancy query reports %d workgroups per CU; nothing launched\n", per_cu); grid = -1; return; }
        (void)hipGetLastError();
#endif
    }
    if (grid < 0) return;
    mk::Params p{};
    const float** pp = (const float**)&p;
    for (int i = 0; i < 27; ++i) pp[i] = (const float*)d_in[i];
    p.out = (float*)d_out; p.ws = (unsigned char*)d_ws;
#if MK_N_LAUNCHES == 1
    (void)hipMemsetAsync((unsigned char*)d_ws + mk::WS_BAR, 0, 16384, stream);
    void* args[] = {&p};
    hipError_t e = hipLaunchCooperativeKernel((const void*)mk::mega_fwd<0, mk::N_PHASES>, dim3(grid), dim3(mk::NTHREADS), args, mk::LDS_BYTES, stream);
    if (e != hipSuccess) fprintf(stderr, "cooperative launch failed: %s (grid %d)\n", hipGetErrorString(e), grid);
#else
#define MK_LAUNCH(k) do { static bool ad_ = false; if (!ad_) { ad_ = true; (void)hipFuncSetAttribute((const void*)mk::mega_fwd<k, k + 1>, hipFuncAttributeMaxDynamicSharedMemorySize, mk::LDS_BYTES); } \
        hipLaunchKernelGGL((mk::mega_fwd<k, k + 1>), dim3(grid), dim3(mk::NTHREADS), mk::LDS_BYTES, stream, p); } while (0)
#ifndef MK_X0
#define MK_X0
#endif
#ifndef MK_X1
#define MK_X1
#endif
#ifndef MK_X2
#define MK_X2
#endif
#ifndef MK_X3
#define MK_X3
#endif
#ifndef MK_X4
#define MK_X4
#endif
#ifndef MK_X5
#define MK_X5
#endif
#ifndef MK_X6
#define MK_X6
#endif
#ifndef MK_X7
#define MK_X7
#endif
#ifndef MK_X8
#define MK_X8
#endif
#ifndef MK_X9
#define MK_X9
#endif
#ifndef MK_X10
#define MK_X10
#endif
#ifndef MK_X11
#define MK_X11
#endif
#ifndef MK_X12
#define MK_X12
#endif
#ifndef MK_X13
#define MK_X13
#endif
#ifndef MK_X14
#define MK_X14
#endif
    MK_X0 MK_LAUNCH(0); MK_X1 MK_LAUNCH(1); MK_X2 MK_LAUNCH(2); MK_X3 MK_LAUNCH(3); MK_X4 MK_LAUNCH(4); MK_X5 MK_LAUNCH(5); MK_X6 MK_LAUNCH(6); MK_X7 MK_LAUNCH(7); MK_X8 MK_LAUNCH(8); MK_X9 MK_LAUNCH(9); MK_X10 MK_LAUNCH(10); MK_X11 MK_LAUNCH(11); MK_X12 MK_LAUNCH(12); MK_X13 MK_LAUNCH(13); MK_X14
#undef MK_LAUNCH
#endif
}
```
